# Optimizing an MI355X kernel written in HIP

```python
import jax, jax.numpy as jnp
from jax import lax
import numpy as np

D_MODEL = 1024
BATCH = 8
SEQ = 2048
DEPTH = 2

GRID_W = 64
CTX_LEN = 256
D_FF = ((8 * D_MODEL // 3 + 255) // 256) * 256
HALF_STEP = 0.5
N_MOD = 9
RMS_EPS = 1e-6
NEG_INF = -1e30

CONV_CH = D_MODEL // 4
CONV_K = 3
POOL_CH = D_MODEL // 4
POOL_WINDOWS = (2, 4, 8, 16)
POOL_GROUP = POOL_CH // 4
NA_HEAD_DIM = 64
NA_CH = D_MODEL // 2
NA_HEADS = NA_CH // NA_HEAD_DIM
NA_KH_MAX = 8
NA_KW = 16
NA_QC = 16
NA_KB = NA_QC + NA_KW - 1
D_MIX = CONV_CH + POOL_CH + NA_CH
OFF_B = CONV_CH
OFF_C = 2 * CONV_CH
OFF_P = 3 * CONV_CH
OFF_Q = 3 * CONV_CH + POOL_CH
OFF_K = OFF_Q + NA_CH
OFF_V = OFF_K + NA_CH
D_IN = OFF_V + NA_CH

kernel_name = 'hybrid_conv_pool_neighbourhood_macaron_dit'


def rms_norm(x, g):
    xf = x.astype(jnp.float32)
    y = xf * lax.rsqrt(jnp.mean(xf * xf, axis=-1, keepdims=True) + RMS_EPS)
    return (y * g.astype(jnp.float32)).astype(x.dtype)


def mod_norm(x, m, i, g):
    return rms_norm(x, g) * (1 + m[:, 3 * i + 1, None]) + m[:, 3 * i, None]


def swiglu(h, w1, w2):
    a, b = jnp.split(h @ w1, 2, axis=-1)
    return (jax.nn.silu(a) * b) @ w2


def ffn_sublayer(x, m, i, g, w1, w2):
    return x + HALF_STEP * m[:, 3 * i + 2, None] * swiglu(mod_norm(x, m, i, g), w1, w2)


def short_conv(u, w):
    return lax.conv_general_dilated(
        u, w[:, None, :].astype(u.dtype), window_strides=(1,),
        padding=[(CONV_K // 2, CONV_K // 2)],
        dimension_numbers=('NWC', 'WIO', 'NWC'), feature_group_count=u.shape[-1])


def gated_conv_mixer(h, b_gate, c_gate, conv_w):
    return b_gate * short_conv(c_gate * h, conv_w)


def multiscale_pool_mixer(v, pool_w, pool_scale):
    L = v.shape[1]
    vf = v.astype(jnp.float32)
    cs = jnp.concatenate([jnp.zeros_like(vf[:, :1]), jnp.cumsum(vf, axis=1)], axis=1)
    t = jnp.arange(L)
    outs = []
    for g, w in enumerate(POOL_WINDOWS):
        left = w // 2
        right = w - 1 - left
        lo = jnp.clip(t - left, 0, L)
        hi = jnp.clip(t + right + 1, 0, L)
        sl = slice(g * POOL_GROUP, (g + 1) * POOL_GROUP)
        mean = (cs[:, hi, sl] - cs[:, lo, sl]) / (hi - lo).astype(jnp.float32)[None, :, None]
        outs.append((mean - vf[..., sl]).astype(v.dtype) @ pool_w[g])
    return jnp.concatenate(outs, axis=-1) * pool_scale


def context_attention(q, k, v):
    B, L = q.shape[:2]
    s = jnp.einsum('bqhd,bkhd->bhqk', q, k, preferred_element_type=jnp.float32) * (NA_HEAD_DIM ** -0.5)
    p = jax.nn.softmax(s, axis=-1).astype(v.dtype)
    return jnp.einsum('bhqk,bkhd->bqhd', p, v).reshape(B, L, NA_CH)


def neighbourhood_attention(q, k, v, k_ctx, v_ctx, rpb):
    B, S = q.shape[:2]
    rows = S // GRID_W
    kh = min(NA_KH_MAX, rows)
    nj = GRID_W // NA_QC
    scale = NA_HEAD_DIM ** -0.5
    qg = q.reshape(B, rows, GRID_W, NA_HEADS, NA_HEAD_DIM)
    kg = k.reshape(B, rows, GRID_W, NA_HEADS, NA_HEAD_DIM)
    vg = v.reshape(B, rows, GRID_W, NA_HEADS, NA_HEAD_DIM)
    qcol = jnp.arange(GRID_W).reshape(nj, NA_QC)
    band0 = jnp.clip(jnp.arange(nj) * NA_QC - NA_KW // 2, 0, GRID_W - NA_KB)
    kcol = band0[:, None] + jnp.arange(NA_KB)
    cstart = jnp.clip(qcol - NA_KW // 2, 0, GRID_W - NA_KW)
    col_valid = (kcol[:, None, :] >= cstart[..., None]) & (kcol[:, None, :] < cstart[..., None] + NA_KW)
    col_off = kcol[:, None, :] - qcol[..., None] + NA_KW - 1
    n_loc = kh * NA_KB

    def row_block(r):
        rs = jnp.clip(r - kh // 2, 0, rows - kh)
        q_r = lax.dynamic_index_in_dim(qg, r, axis=1, keepdims=False).reshape(
            B, nj, NA_QC, NA_HEADS, NA_HEAD_DIM)
        k_b = lax.dynamic_slice_in_dim(kg, rs, kh, axis=1)[:, :, kcol]
        v_b = lax.dynamic_slice_in_dim(vg, rs, kh, axis=1)[:, :, kcol]
        row_off = rs + jnp.arange(kh) - r + NA_KH_MAX - 1
        bias = rpb[:, row_off[None, None, :, None], col_off[:, :, None, :]].astype(jnp.float32)
        bias = jnp.where(col_valid[None, :, :, None, :], bias, NEG_INF)
        s_loc = jnp.einsum('bjqhd,bijkhd->bhjqik', q_r, k_b,
                           preferred_element_type=jnp.float32) * scale + bias
        s_ctx = jnp.einsum('bjqhd,bchd->bhjqc', q_r, k_ctx,
                           preferred_element_type=jnp.float32) * scale
        s = jnp.concatenate([s_loc.reshape(B, NA_HEADS, nj, NA_QC, n_loc), s_ctx], axis=-1)
        p = jax.nn.softmax(s, axis=-1).astype(v.dtype)
        p_loc = p[..., :n_loc].reshape(B, NA_HEADS, nj, NA_QC, kh, NA_KB)
        o = (jnp.einsum('bhjqik,bijkhd->bjqhd', p_loc, v_b)
             + jnp.einsum('bhjqc,bchd->bjqhd', p[..., n_loc:], v_ctx))
        return o.reshape(B, GRID_W, NA_CH)

    out = lax.map(row_block, jnp.arange(rows))
    return out.transpose(1, 0, 2, 3).reshape(B, S, NA_CH)


def heads(t):
    return t.reshape(t.shape[0], t.shape[1], NA_HEADS, NA_HEAD_DIM)


def setup_inputs(seed: int = 0) -> dict:
    key = jax.random.key(seed)
    ks = jax.random.split(key, 16)
    f32 = jnp.float32
    nrm = lambda k, shape, s: jax.random.normal(k, shape, f32) * s
    return {
        'x': nrm(ks[0], (BATCH, SEQ, D_MODEL), 1.0),
        'c': nrm(ks[1], (BATCH, D_MODEL), 1.0),
        'ctx': nrm(ks[2], (BATCH, CTX_LEN, D_MODEL), 1.0),
        'c_ctx': nrm(ks[3], (D_MODEL,), 1.0),
        'w_mod': nrm(ks[4], (DEPTH, D_MODEL, N_MOD * D_MODEL), 0.5 * D_MODEL ** -0.5),
        'b_mod': nrm(ks[5], (DEPTH, N_MOD * D_MODEL), 0.01),
        'norm_g': 1.0 + nrm(ks[6], (DEPTH, 3, D_MODEL), 0.02),
        'ffn_w_in': nrm(ks[7], (DEPTH, 2, D_MODEL, 2 * D_FF), D_MODEL ** -0.5),
        'ffn_w_out': nrm(ks[8], (DEPTH, 2, D_FF, D_MODEL), D_FF ** -0.5),
        'w_in': nrm(ks[9], (DEPTH, D_MODEL, D_IN), D_MODEL ** -0.5),
        'conv_w': nrm(ks[10], (DEPTH, CONV_K, CONV_CH), CONV_K ** -0.5),
        'pool_w': nrm(ks[11], (DEPTH, len(POOL_WINDOWS), POOL_GROUP, POOL_GROUP), POOL_GROUP ** -0.5),
        'pool_scale': 1.0 + nrm(ks[12], (DEPTH, POOL_CH), 0.1),
        'rpb': nrm(ks[13], (DEPTH, NA_HEADS, 2 * NA_KH_MAX - 1, 2 * NA_KW - 1), 0.1),
        'w_out': nrm(ks[14], (DEPTH, D_MIX, D_MODEL), D_MIX ** -0.5),
        'final_g': 1.0 + nrm(ks[15], (D_MODEL,), 0.02),
    }


def reference(x, c, ctx, c_ctx, w_mod, b_mod, norm_g, ffn_w_in, ffn_w_out, w_in,
              conv_w, pool_w, pool_scale, rpb, w_out, final_g):
    B = x.shape[0]
    xc = ctx
    for l in range(DEPTH):
        last = l == DEPTH - 1
        m = (jax.nn.silu(c) @ w_mod[l] + b_mod[l]).reshape(B, N_MOD, D_MODEL)
        mc = (jax.nn.silu(c_ctx) @ w_mod[l] + b_mod[l]).reshape(1, N_MOD, D_MODEL)

        x = ffn_sublayer(x, m, 0, norm_g[l, 0], ffn_w_in[l, 0], ffn_w_out[l, 0])
        xc = ffn_sublayer(xc, mc, 0, norm_g[l, 0], ffn_w_in[l, 0], ffn_w_out[l, 0])

        h = mod_norm(x, m, 1, norm_g[l, 1])
        hc = mod_norm(xc, mc, 1, norm_g[l, 1])
        u = h @ w_in[l]
        if last:
            uc_kv = hc @ w_in[l][:, OFF_K:]
            kc, vc = heads(uc_kv[..., :NA_CH]), heads(uc_kv[..., NA_CH:])
        else:
            uc = hc @ w_in[l]
            kc, vc = heads(uc[..., OFF_K:OFF_V]), heads(uc[..., OFF_V:])
            yc = jnp.concatenate([
                gated_conv_mixer(uc[..., :OFF_B], uc[..., OFF_B:OFF_C], uc[..., OFF_C:OFF_P], conv_w[l]),
                multiscale_pool_mixer(uc[..., OFF_P:OFF_Q], pool_w[l], pool_scale[l]),
                context_attention(heads(uc[..., OFF_Q:OFF_K]), kc, vc),
            ], axis=-1) @ w_out[l]
            xc = xc + mc[:, 5, None] * yc
            xc = ffn_sublayer(xc, mc, 2, norm_g[l, 2], ffn_w_in[l, 1], ffn_w_out[l, 1])
        y = jnp.concatenate([
            gated_conv_mixer(u[..., :OFF_B], u[..., OFF_B:OFF_C], u[..., OFF_C:OFF_P], conv_w[l]),
            multiscale_pool_mixer(u[..., OFF_P:OFF_Q], pool_w[l], pool_scale[l]),
            neighbourhood_attention(heads(u[..., OFF_Q:OFF_K]), heads(u[..., OFF_K:OFF_V]),
                                    heads(u[..., OFF_V:]), kc, vc, rpb[l]),
        ], axis=-1) @ w_out[l]
        x = x + m[:, 5, None] * y

        x = ffn_sublayer(x, m, 2, norm_g[l, 2], ffn_w_in[l, 1], ffn_w_out[l, 1])
    return rms_norm(x, final_g)
```

```cpp
#include <hip/hip_runtime.h>
#include <hip/hip_cooperative_groups.h>
#include <cstdio>
#include <cstdint>
namespace cg = cooperative_groups;
#ifndef MK_COOP
#define MK_COOP 1
#endif
namespace pg8 {
#define PG8_LAS __attribute__((address_space(3)))
typedef unsigned short bf16_t;
typedef short bf16x8 __attribute__((ext_vector_type(8)));
typedef float f32x4 __attribute__((ext_vector_type(4)));
typedef unsigned u32x4 __attribute__((ext_vector_type(4)));
constexpr int BM = 256, BK = 64, HALF = 128, HTB = HALF * BK * 2  , STAGE_BYTES = 8 * HTB, NXCD = 8, WGM = 8;

__host__ __device__ __forceinline__ int lds_byte(int r, int c) { const int st = (r >> 4) * 2 + (c >> 5), rr = r & 15, cc = c & 31, ob = rr * 64 + cc * 2; return st * 1024 + (ob ^ (((ob >> 9) & 1) << 5)); }
__host__ __device__ __forceinline__ void stage_rc(int b, int& R, int& C) { const int st = b / 1024, sb = b % 1024, swz = sb ^ (((sb >> 9) & 1) << 5); R = (st >> 1) * 16 + swz / 64; C = (st & 1) * 32 + (swz % 64) / 2; }
__host__ __device__ __forceinline__ int perm32(int rho) { const int n = rho >> 4, i = rho & 15; return 8 * (i >> 2) + 4 * n + (i & 3); }

struct Unit { int pm, pn; };
struct Gemm { const bf16_t* A; const bf16_t* Bt; int M, N, K; };

struct StaticOrder {
    int nM, nN, nwg, G, c;
    __host__ __device__ void init(int M, int N, int G_, int c_) { nM = M / BM; nN = N / BM; nwg = nM * nN; G = G_; c = c_; }
    __host__ __device__ bool next(int i, Unit& u) const {
        const long L = (long)i * G + c; if (L >= nwg) return false;
        int wgid = (int)L; { const int q = nwg / NXCD, r = nwg % NXCD, xcd = wgid % NXCD, off = wgid / NXCD; wgid = (xcd < r ? xcd * (q + 1) : r * (q + 1) + (xcd - r) * q) + off; }
        const int nig = WGM * nN, gid = wgid / nig, fm = gid * WGM, gsz = (nM - fm) < WGM ? (nM - fm) : WGM;
        u.pm = fm + ((wgid % nig) % gsz); u.pn = (wgid % nig) / gsz; return true;
    }
    __device__ __forceinline__ void a_ready(const Unit&) const {}
    __device__ __forceinline__ void done(const Unit&) const {}
};

__device__ __forceinline__ unsigned cvt_pk_bf16(float lo, float hi) { unsigned r; asm volatile("v_cvt_pk_bf16_f32 %0, %1, %2" : "=v"(r) : "v"(lo), "v"(hi)); return r; }
constexpr int LAT_TILES = 64;
typedef unsigned u32x2 __attribute__((ext_vector_type(2)));
__device__ __forceinline__ float silu_f(float a) { return a * __builtin_amdgcn_rcpf(1.0f + __builtin_amdgcn_exp2f(-1.44269504089f * a)); }
struct EpiSwiglu {
    static constexpr bool PERM = true, AFTER_DRAIN = false;
    bf16_t* H; int ldh;
    __device__ __forceinline__ void operator()(const f32x4 (&acc)[2][2][4][2], const Unit& u, int wr, int wc, int fr, int fq) const {
        const int row0 = u.pm * BM + wr * 64 + fr, col0 = u.pn * HALF + wc * 32 + 8 * fq;
#pragma unroll
        for (int ai = 0; ai < 2; ++ai)
#pragma unroll
            for (int m = 0; m < 4; ++m) { bf16_t* rowp = H + (size_t)(row0 + ai * HALF + m * 16) * ldh + col0;
                const f32x4 a0 = acc[ai][0][m][0], a1 = acc[ai][0][m][1], b0 = acc[ai][1][m][0], b1 = acc[ai][1][m][1];
                u32x4 w; w.x = cvt_pk_bf16(silu_f(a0[0]) * b0[0], silu_f(a0[1]) * b0[1]); w.y = cvt_pk_bf16(silu_f(a0[2]) * b0[2], silu_f(a0[3]) * b0[3]);
                w.z = cvt_pk_bf16(silu_f(a1[0]) * b1[0], silu_f(a1[1]) * b1[1]); w.w = cvt_pk_bf16(silu_f(a1[2]) * b1[2], silu_f(a1[3]) * b1[3]);
                *(u32x4*)rowp = w; }
    }
};
struct EpiResid {
    static constexpr bool PERM = false, AFTER_DRAIN = false;
    const float* base_lat; const float* base_ctx; float* out_lat; float* out_ctx; const float* gate; float coef;
    __device__ __forceinline__ void operator()(const f32x4 (&acc)[2][2][4][2], const Unit& u, int wr, int wc, int fr, int fq) const {
        const bool lat = u.pm < LAT_TILES; const int mb = lat ? (u.pm >> 3) : 8;
        const size_t toff = (size_t)(lat ? u.pm : u.pm - LAT_TILES) * BM * 1024;
        const float* bp = (lat ? base_lat : base_ctx) + toff; float* op = (lat ? out_lat : out_ctx) + toff;
        const int col0 = u.pn * BM + wc * 32 + 4 * fq; const float* g = gate + (size_t)mb * 9216 + col0;
        f32x4 gv[2][2];
#pragma unroll
        for (int bj = 0; bj < 2; ++bj)
#pragma unroll
            for (int n = 0; n < 2; ++n) gv[bj][n] = *(const f32x4*)(g + bj * HALF + n * 16) * coef;
#pragma unroll
        for (int ai = 0; ai < 2; ++ai)
#pragma unroll
            for (int m = 0; m < 4; ++m) { const size_t off = (size_t)(ai * HALF + wr * 64 + m * 16 + fr) * 1024 + col0;
#pragma unroll
                for (int bj = 0; bj < 2; ++bj)
#pragma unroll
                    for (int n = 0; n < 2; ++n) { const f32x4 bs = *(const f32x4*)(bp + off + bj * HALF + n * 16);
                        *(f32x4*)(op + off + bj * HALF + n * 16) = bs + gv[bj][n] * acc[ai][bj][m][n]; } }
    }
};
struct EpiU {
    static constexpr bool PERM = true, AFTER_DRAIN = false;
    bf16_t* U; bf16_t* VTl; bf16_t* VTc;
    __device__ __forceinline__ void operator()(const f32x4 (&acc)[2][2][4][2], const Unit& u, int wr, int wc, int fr, int fq) const {
        if (u.pn < 8) {
            const float sc = (u.pn == 4 || u.pn == 5) ? 0.125f : 1.0f;
            const int row0 = u.pm * BM + wr * 64 + fr, col0 = u.pn * BM + wc * 32 + 8 * fq;
#pragma unroll
            for (int ai = 0; ai < 2; ++ai)
#pragma unroll
                for (int m = 0; m < 4; ++m) { bf16_t* rowp = U + (size_t)(row0 + ai * HALF + m * 16) * 2048 + col0;
#pragma unroll
                    for (int bj = 0; bj < 2; ++bj) { const f32x4 v0 = acc[ai][bj][m][0] * sc, v1 = acc[ai][bj][m][1] * sc;
                        u32x4 w; w.x = cvt_pk_bf16(v0[0], v0[1]); w.y = cvt_pk_bf16(v0[2], v0[3]); w.z = cvt_pk_bf16(v1[0], v1[1]); w.w = cvt_pk_bf16(v1[2], v1[3]);
                        *(u32x4*)(rowp + bj * HALF) = w; } }
        } else {
            const bool lat = u.pm < LAT_TILES;
            const int T = lat ? 2048 : 256;
            const int rloc = (lat ? u.pm : u.pm - LAT_TILES) * BM + wr * 64 + fr;
            bf16_t* vt = lat ? VTl : VTc;
#pragma unroll
            for (int ai = 0; ai < 2; ++ai)
#pragma unroll
                for (int m = 0; m < 4; ++m) { const int rr = rloc + ai * HALF + m * 16; const int b = lat ? (rr >> 11) : (rr >> 8), t = lat ? (rr & 2047) : (rr & 255);
#pragma unroll
                    for (int bj = 0; bj < 2; ++bj)
#pragma unroll
                        for (int n = 0; n < 2; ++n) { const int cv = (u.pn - 8) * BM + bj * HALF + wc * 32 + 8 * fq + 4 * n;
                            bf16_t* p = vt + ((size_t)b * 512 + cv) * T + t; const f32x4 v = acc[ai][bj][m][n];
                            const unsigned w0 = cvt_pk_bf16(v[0], v[1]), w1 = cvt_pk_bf16(v[2], v[3]);
                            p[0] = (bf16_t)(w0 & 0xffffu); p[T] = (bf16_t)(w0 >> 16); p[2 * (size_t)T] = (bf16_t)(w1 & 0xffffu); p[3 * (size_t)T] = (bf16_t)(w1 >> 16); } }
        }
    }
};
template <class Epi, class Sched, bool ALIGN_EPI = false, bool SP2 = false>
__device__ __forceinline__ void gemm_phase(PG8_LAS unsigned char* lds, const Gemm g, const Sched& S, const Epi& E) {
    int tid_l = threadIdx.x; asm volatile("" : "+v"(tid_l));
    const int tid = tid_l, wid = __builtin_amdgcn_readfirstlane(tid >> 6), lane = tid & 63, wr = wid >> 2, wc = wid & 3, fr = lane & 15, fq = lane >> 4;
    const int K = g.K, nt = K / BK;
    unsigned voffA[2], voffB[2];
#pragma unroll
    for (int i = 0; i < 2; ++i) { int R, C; stage_rc(tid * 16 + i * 8192, R, C); const int Rb = Epi::PERM ? ((R & ~31) + perm32(R & 31)) : R;
        voffA[i] = (unsigned)(R * K + C) * 2u; voffB[i] = (unsigned)(Rb * K + C) * 2u; }
    const size_t kstep = (size_t)(BK * 2);
    const size_t hstep = (size_t)HALF * K * 2;
    const size_t tstep = 2 * hstep;
    const unsigned ldsw = (unsigned)wid * 1024u;
    const int aoff = lds_byte(wr * 64 + fr, fq * 8), boff = lds_byte(wc * 32 + fr, fq * 8);
#define PG8_SA(b, h) (((b) * 2 + (h)) * HTB)
#define PG8_SB(b, h) ((4 + (b) * 2 + (h)) * HTB)
#define PG8_STAGE(bufoff, gbase, voff) do { _Pragma("unroll") for (int _i = 0; _i < 2; ++_i) \
        __builtin_amdgcn_global_load_lds((const unsigned*)((const char*)(gbase) + (voff)[_i]), (PG8_LAS unsigned*)(lds + (bufoff) + ldsw + _i * 8192), 16, 0, 0); } while (0)
#define PG8_LDA(dst, b, h) do { _Pragma("unroll") for (int m = 0; m < 4; ++m) _Pragma("unroll") for (int k = 0; k < 2; ++k) dst[m][k] = *(const PG8_LAS bf16x8*)(lds + PG8_SA(b, h) + aoff + m * 2048 + k * 1024); } while (0)
#define PG8_LDB(dst, b, h) do { _Pragma("unroll") for (int n = 0; n < 2; ++n) _Pragma("unroll") for (int k = 0; k < 2; ++k) dst[n][k] = *(const PG8_LAS bf16x8*)(lds + PG8_SB(b, h) + boff + n * 2048 + k * 1024); } while (0)
#define PG8_MMA(ai, bj, At, Bt) do { __builtin_amdgcn_s_setprio(1); _Pragma("unroll") for (int m = 0; m < 4; ++m) _Pragma("unroll") for (int n = 0; n < 2; ++n) _Pragma("unroll") for (int k = 0; k < 2; ++k) \
        acc[ai][bj][m][n] = __builtin_amdgcn_mfma_f32_16x16x32_bf16(Bt[n][k], At[m][k], acc[ai][bj][m][n], 0, 0, 0); __builtin_amdgcn_s_setprio(0); } while (0)
#define PG8_WAIT_V(n) asm volatile("s_waitcnt vmcnt(" #n ")" ::: "memory")
#define PG8_WAIT_L(n) asm volatile("s_waitcnt lgkmcnt(" #n ")" ::: "memory")
#define PG8_BAR __builtin_amdgcn_s_barrier()
#define PG8_SCHED __builtin_amdgcn_sched_barrier(0)
    Unit cur, nxt; int ui = 0;
    if (!S.next(0, cur)) return;
    f32x4 acc[2][2][4][2];
#pragma unroll
    for (int a = 0; a < 2; ++a)
#pragma unroll
        for (int b = 0; b < 2; ++b)
#pragma unroll
            for (int m = 0; m < 4; ++m)
#pragma unroll
                for (int n = 0; n < 2; ++n) acc[a][b][m][n] = (f32x4){0.f, 0.f, 0.f, 0.f};
    bf16x8 At[4][2], B0[2][2], B1[2][2];
    const char* cA = (const char*)g.A + (size_t)cur.pm * tstep; const char* cB = (const char*)g.Bt + (size_t)cur.pn * tstep;
    S.a_ready(cur);
    if constexpr (SP2) {
        PG8_STAGE(PG8_SB(0, 0), cB, voffB); PG8_STAGE(PG8_SB(0, 1), cB + hstep, voffB); PG8_STAGE(PG8_SA(0, 0), cA, voffA); PG8_STAGE(PG8_SA(0, 1), cA + hstep, voffA);
        if (wr == 1) PG8_BAR;
        PG8_WAIT_V(2); PG8_BAR;
        PG8_STAGE(PG8_SB(1, 0), cB + kstep, voffB); PG8_STAGE(PG8_SA(1, 0), cA + kstep, voffA); PG8_STAGE(PG8_SB(1, 1), cB + hstep + kstep, voffB);
        PG8_WAIT_V(6); PG8_BAR;
    } else {
        PG8_STAGE(PG8_SB(0, 0), cB, voffB); PG8_STAGE(PG8_SA(0, 0), cA, voffA); PG8_STAGE(PG8_SB(0, 1), cB + hstep, voffB); PG8_STAGE(PG8_SA(0, 1), cA + hstep, voffA);
        if (wr == 1) PG8_BAR;
        PG8_WAIT_V(4); PG8_BAR;
        PG8_STAGE(PG8_SB(1, 0), cB + kstep, voffB); PG8_STAGE(PG8_SA(1, 0), cA + kstep, voffA); PG8_STAGE(PG8_SB(1, 1), cB + hstep + kstep, voffB);
        PG8_WAIT_V(6); PG8_BAR;
    }
    for (;;) {
        const bool has_next = S.next(ui + 1, nxt);
        const char* nA = has_next ? (const char*)g.A + (size_t)nxt.pm * tstep : cA; const char* nB = has_next ? (const char*)g.Bt + (size_t)nxt.pn * tstep : cB;
        for (int t = 0; t < nt; t += 2) {
            const bool last = (t == nt - 2);
            const char* a1 = cA + (size_t)(t + 1) * kstep;
            const char* a2 = last ? nA : cA + (size_t)(t + 2) * kstep; const char* b2 = last ? nB : cB + (size_t)(t + 2) * kstep;
            const char* a3 = a2 + kstep; const char* b3 = b2 + kstep;
            if (last && has_next) S.a_ready(nxt);
            if constexpr (SP2) {
            PG8_LDB(B0, 0, 0); PG8_LDB(B1, 0, 1); PG8_SCHED; PG8_LDA(At, 0, 0); PG8_STAGE(PG8_SA(1, 1), a1 + hstep, voffA);
            PG8_WAIT_V(8); PG8_WAIT_L(0); PG8_BAR; PG8_MMA(0, 0, At, B0); PG8_MMA(0, 1, At, B1); PG8_BAR; PG8_SCHED;
            PG8_LDA(At, 0, 1); PG8_STAGE(PG8_SB(0, 0), b2, voffB); PG8_STAGE(PG8_SB(0, 1), b2 + hstep, voffB); PG8_STAGE(PG8_SA(0, 0), a2, voffA);
            PG8_WAIT_V(8); PG8_WAIT_L(0); PG8_BAR; PG8_MMA(1, 0, At, B0); PG8_MMA(1, 1, At, B1); PG8_BAR; PG8_SCHED;
            PG8_LDB(B0, 1, 0); PG8_LDB(B1, 1, 1); PG8_SCHED; PG8_LDA(At, 1, 0); PG8_STAGE(PG8_SA(0, 1), a2 + hstep, voffA);
            PG8_WAIT_V(8); PG8_WAIT_L(0); PG8_BAR; PG8_MMA(0, 0, At, B0); PG8_MMA(0, 1, At, B1); PG8_BAR; PG8_SCHED;
            PG8_LDA(At, 1, 1); PG8_STAGE(PG8_SB(1, 0), b3, voffB); PG8_STAGE(PG8_SB(1, 1), b3 + hstep, voffB); PG8_STAGE(PG8_SA(1, 0), a3, voffA);
            PG8_WAIT_V(8); PG8_WAIT_L(0); PG8_BAR; PG8_MMA(1, 0, At, B0); PG8_MMA(1, 1, At, B1); PG8_BAR; PG8_SCHED;
            } else {
            PG8_LDB(B0, 0, 0); PG8_SCHED; PG8_LDA(At, 0, 0); PG8_STAGE(PG8_SA(1, 1), a1 + hstep, voffA);
            PG8_WAIT_L(8); PG8_BAR; PG8_WAIT_L(0); PG8_MMA(0, 0, At, B0); PG8_BAR; PG8_SCHED;
            PG8_LDB(B1, 0, 1); PG8_STAGE(PG8_SB(0, 0), b2, voffB);
            PG8_BAR; PG8_WAIT_L(0); PG8_MMA(0, 1, At, B1); PG8_BAR;
            PG8_LDA(At, 0, 1); PG8_STAGE(PG8_SA(0, 0), a2, voffA);
            PG8_BAR; PG8_WAIT_L(0); PG8_MMA(1, 0, At, B0); PG8_BAR; PG8_SCHED;
            PG8_STAGE(PG8_SB(0, 1), b2 + hstep, voffB);
            PG8_WAIT_V(6); PG8_BAR; PG8_MMA(1, 1, At, B1); PG8_BAR;
            PG8_LDB(B0, 1, 0); PG8_SCHED; PG8_LDA(At, 1, 0); PG8_STAGE(PG8_SA(0, 1), a2 + hstep, voffA);
            PG8_WAIT_L(8); PG8_BAR; PG8_WAIT_L(0); PG8_MMA(0, 0, At, B0); PG8_BAR; PG8_SCHED;
            PG8_LDB(B1, 1, 1); PG8_STAGE(PG8_SB(1, 0), b3, voffB);
            PG8_BAR; PG8_WAIT_L(0); PG8_MMA(0, 1, At, B1); PG8_BAR;
            PG8_LDA(At, 1, 1); PG8_STAGE(PG8_SA(1, 0), a3, voffA);
            PG8_BAR; PG8_WAIT_L(0); PG8_MMA(1, 0, At, B0); PG8_BAR; PG8_SCHED;
            PG8_STAGE(PG8_SB(1, 1), b3 + hstep, voffB);
            PG8_WAIT_V(6); PG8_BAR; PG8_MMA(1, 1, At, B1); PG8_BAR;
            }
        }
        if constexpr (ALIGN_EPI) { if (wr == 0) PG8_BAR; }
        if constexpr (!Epi::AFTER_DRAIN) { E(acc, cur, wr, wc, fr, fq); S.done(cur); }
        if (!has_next) break;
#pragma unroll
        for (int a = 0; a < 2; ++a)
#pragma unroll
            for (int b = 0; b < 2; ++b)
#pragma unroll
                for (int m = 0; m < 4; ++m)
#pragma unroll
                    for (int n = 0; n < 2; ++n) acc[a][b][m][n] = (f32x4){0.f, 0.f, 0.f, 0.f};
        cur = nxt; cA = nA; cB = nB; ++ui;
        if constexpr (ALIGN_EPI) { if (wr == 1) PG8_BAR; }
    }
    PG8_WAIT_V(0);
    if constexpr (!ALIGN_EPI) { if (wr == 0) PG8_BAR; }
    PG8_BAR;
    if constexpr (Epi::AFTER_DRAIN) { E.fused(acc, cur, wr, wc, fr, fq, lds, wid, lane); S.done(cur); }
#undef PG8_SA
#undef PG8_SB
#undef PG8_STAGE
#undef PG8_LDA
#undef PG8_LDB
#undef PG8_MMA
#undef PG8_WAIT_V
#undef PG8_WAIT_L
#undef PG8_BAR
#undef PG8_SCHED
}
}

#define GAS __attribute__((address_space(1)))
#define LAS __attribute__((address_space(3)))
typedef unsigned short bf16;
typedef unsigned v4u __attribute__((ext_vector_type(4)));
typedef unsigned v2u __attribute__((ext_vector_type(2)));
typedef float f32x4 __attribute__((ext_vector_type(4)));
typedef float f32x2 __attribute__((ext_vector_type(2)));
typedef short bf16x8 __attribute__((ext_vector_type(8)));
typedef short s16x4 __attribute__((ext_vector_type(4)));
typedef __bf16 bf16x2v __attribute__((ext_vector_type(2)));
__device__ __forceinline__ unsigned pk2(float lo, float hi) { return __builtin_bit_cast(unsigned, __builtin_convertvector((f32x2){lo, hi}, bf16x2v)); }
__device__ __forceinline__ float bf2f(unsigned short h) { return __builtin_bit_cast(float, (unsigned)h << 16); }
#define LDS_WAIT() asm volatile("s_waitcnt lgkmcnt(0)" ::: "memory")

constexpr int NWAVES = 8, NTHREADS = 512;
constexpr int D = 1024, BATCH = 8, SEQ = 2048, CTX = 256, DFF = 2816, NMODC = 9216;
constexpr int MLAT = BATCH * SEQ, MCTX = BATCH * CTX, MT = MLAT + MCTX;
constexpr float RMS_EPS = 1e-6f;
constexpr int UW = 2048;
constexpr int OFFQ = 1024, OFFK = 1536;
constexpr size_t MiB = 1u << 20;
constexpr size_t WS_MOD = 1 * MiB;
constexpr size_t WS_W = 2 * MiB, W_LAYER = 40 * MiB;
constexpr size_t WO_W1A = 0, WO_W2A = 11 * MiB, WO_WIN = 11 * MiB + 5632 * 1024, WO_WOUT = WO_WIN + 5 * MiB, WO_W1B = WO_WOUT + 2 * MiB, WO_W2B = WO_W1B + 11 * MiB;
static_assert(WO_W2B + 5632 * 1024 == W_LAYER, "weights map");
constexpr size_t WS_WF = 279 * MiB;
constexpr size_t WS_XC = 82 * MiB;
constexpr size_t WS_XN = 90 * MiB;
constexpr size_t WS_H = 126 * MiB;
constexpr size_t WS_Y = 225 * MiB;
constexpr size_t WS_VTL = 261 * MiB, WS_VTC = 277 * MiB, WS_END = 281 * MiB;
constexpr int LDS_BYTES = 131072 + 1024;

struct Args { const float* in[16]; float* out; unsigned char* ws; int ph_lo, ph_hi, coop, pad; };
enum { I_X = 0, I_C, I_CTX, I_CCTX, I_WMOD, I_BMOD, I_NORMG, I_FWIN, I_FWOUT, I_WIN, I_CONVW, I_POOLW, I_POOLS, I_RPB, I_WOUT, I_FINALG };

__device__ __forceinline__ float wave_sum(float v) {
#pragma unroll
    for (int o = 1; o < 64; o <<= 1) v += __shfl_xor(v, o);
    return v;
}

__device__ __forceinline__ void mod_gemv_item(const Args& a, LAS unsigned char* lds, int item, int tid, int wave, int lane) {
    const int l = item / 36, chunk = item % 36;
    LAS float* sc = (LAS float*)lds;
    LAS float* red = (LAS float*)(lds + 40960);
    const float* c = a.in[I_C]; const float* cc = a.in[I_CCTX];
    for (int i = tid; i < 9 * 1024; i += NTHREADS) { const int mb = i >> 10, k = i & 1023; const float v = mb < 8 ? c[mb * 1024 + k] : cc[k]; sc[i] = v / (1.0f + __expf(-v)); }
    __syncthreads();
    const float* W = a.in[I_WMOD] + (size_t)l * 1024 * NMODC + 256 * chunk + 4 * lane;
    f32x4 acc[9];
#pragma unroll
    for (int mb = 0; mb < 9; ++mb) acc[mb] = (f32x4){0.f, 0.f, 0.f, 0.f};
    const int k0 = wave * 128;
#pragma unroll 2
    for (int kk = 0; kk < 128; kk += 4) {
        const f32x4 w0 = *(const f32x4*)(W + (size_t)(k0 + kk) * NMODC), w1 = *(const f32x4*)(W + (size_t)(k0 + kk + 1) * NMODC),
                    w2 = *(const f32x4*)(W + (size_t)(k0 + kk + 2) * NMODC), w3 = *(const f32x4*)(W + (size_t)(k0 + kk + 3) * NMODC);
#pragma unroll
        for (int mb = 0; mb < 9; ++mb) { const f32x4 s4 = *(const LAS f32x4*)(sc + mb * 1024 + k0 + kk); acc[mb] += w0 * s4.x + w1 * s4.y + w2 * s4.z + w3 * s4.w; }
    }
#pragma unroll
    for (int mb = 0; mb < 9; ++mb) *(LAS f32x4*)(red + (wave * 9 + mb) * 256 + 4 * lane) = acc[mb];
    __syncthreads();
    float* MOD = (float*)(a.ws + WS_MOD);
    for (int o = tid; o < 9 * 256; o += NTHREADS) { const int mb = o >> 8, col = o & 255; float s = a.in[I_BMOD][l * NMODC + 256 * chunk + col];
#pragma unroll
        for (int w = 0; w < 8; ++w) s += red[(w * 9 + mb) * 256 + col];
        MOD[(size_t)(l * 9 + mb) * NMODC + 256 * chunk + col] = s; }
    __syncthreads();
}
__device__ __forceinline__ void transpose_item(const float* W, int K, int N, bf16* WT, int kind, const float* pw, const float* ps, LAS float* scr, int item, int lane) {
    const int nblk = N / 32, kb = item / nblk, nb = item % nblk, k0 = 64 * kb, n0 = 32 * nb;
    int drow = n0;
    if (kind == 1) { drow = n0 < DFF ? 256 * (n0 / 128) + (n0 % 128) : 256 * ((n0 - DFF) / 128) + 128 + ((n0 - DFF) % 128); }
    if (kind == 2 && kb >= 4 && kb < 8) {
#pragma unroll 8
        for (int i = 0; i < 32; ++i) { const int kk = 2 * i + (lane >> 5); scr[kk * 33 + (lane & 31)] = pw[(size_t)(k0 - 256 + kk) * N + n0 + (lane & 31)]; }
    } else {
#pragma unroll 8
        for (int i = 0; i < 32; ++i) { const int kk = 2 * i + (lane >> 5); scr[kk * 33 + (lane & 31)] = W[(size_t)(k0 + kk) * N + n0 + (lane & 31)]; }
    }
    LDS_WAIT(); asm volatile("" ::: "memory");
    const int c = lane & 7;
#pragma unroll
    for (int j = 0; j < 4; ++j) { const int n = (lane >> 3) + 8 * j; const LAS float* s = scr + (8 * c) * 33 + n;
        v4u o; o.x = pk2(s[0 * 33], s[1 * 33]); o.y = pk2(s[2 * 33], s[3 * 33]); o.z = pk2(s[4 * 33], s[5 * 33]); o.w = pk2(s[6 * 33], s[7 * 33]);
        *(v4u*)(WT + (size_t)(drow + n) * K + k0 + 8 * c) = o; }
    LDS_WAIT(); asm volatile("" ::: "memory");
}
__device__ __forceinline__ void prologue(const Args& a, LAS unsigned char* lds, int tid, int wave, int lane) {
    if ((int)blockIdx.x < 72) mod_gemv_item(a, lds, blockIdx.x, tid, wave, lane);
    LAS float* scr = (LAS float*)(lds + wave * 16384);
    const int gw = blockIdx.x * NWAVES + wave, NGW = gridDim.x * NWAVES;
    constexpr int I1 = 16 * 176, I2 = 44 * 32, I3 = 16 * 80, PER_L = 2 * I1 + 2 * I2 + I3;
    for (int it = gw; it < 2 * PER_L; it += NGW) {
        const int l = it / PER_L; int r = it % PER_L;
        unsigned char* wb = a.ws + WS_W + (size_t)l * W_LAYER;
        const float* fwin = a.in[I_FWIN] + (size_t)l * 2 * D * 2 * DFF; const float* fwout = a.in[I_FWOUT] + (size_t)l * 2 * DFF * D;
        if (r < I1) { transpose_item(fwin, D, 2 * DFF, (bf16*)(wb + WO_W1A), 1, nullptr, nullptr, scr, r, lane); continue; } r -= I1;
        if (r < I2) { transpose_item(fwout, DFF, D, (bf16*)(wb + WO_W2A), 0, nullptr, nullptr, scr, r, lane); continue; } r -= I2;
        if (r < I3) { transpose_item(a.in[I_WIN] + (size_t)l * D * 2560, D, 2560, (bf16*)(wb + WO_WIN), 0, nullptr, nullptr, scr, r, lane); continue; } r -= I3;
        if (r < I1) { transpose_item(fwin + (size_t)D * 2 * DFF, D, 2 * DFF, (bf16*)(wb + WO_W1B), 1, nullptr, nullptr, scr, r, lane); continue; } r -= I1;
        transpose_item(fwout + (size_t)DFF * D, DFF, D, (bf16*)(wb + WO_W2B), 0, nullptr, nullptr, scr, r, lane);
    }
    float* Wf = (float*)(a.ws + WS_WF);
    for (int it = gw; it < 2 * 256 * 16; it += NGW) {
        const int l = it >> 12, row = (it >> 4) & 255, n = (it & 15) * 64 + lane, g = row >> 6;
        const float* p = a.in[I_POOLW] + ((size_t)l * 256 + row) * 64; const float* ps = a.in[I_POOLS] + l * 256 + 64 * g;
        const float* w = a.in[I_WOUT] + (size_t)l * D * D + (size_t)(256 + 64 * g) * D + n; float sacc = 0.f;
#pragma unroll 8
        for (int j = 0; j < 64; ++j) sacc += p[j] * ps[j] * w[(size_t)j * D];
        Wf[((size_t)l * 256 + row) * D + n] = sacc;
    }
}
__device__ __forceinline__ void wout_transposes(const Args& a, LAS unsigned char* lds, int wave, int lane) {
    LAS float* scr = (LAS float*)(lds + wave * 16384);
    const int gw = blockIdx.x * NWAVES + wave, NGW = gridDim.x * NWAVES;
    for (int it = gw; it < 2 * 512; it += NGW) { const int l = it >> 9;
        transpose_item(a.in[I_WOUT] + (size_t)l * D * D, D, D, (bf16*)(a.ws + WS_W + (size_t)l * W_LAYER + WO_WOUT), 2, (const float*)(a.ws + WS_WF) + (size_t)l * 256 * D, nullptr, scr, it & 511, lane); }
}
__device__ __forceinline__ void norm_phase(const float* src_lat, const float* src_ctx, bf16* XN, const float* g, const float* modl  , int s, int nrows, int wave, int lane) {
    const int gw = blockIdx.x * NWAVES + wave, NGW = gridDim.x * NWAVES;
    for (int row = gw; row < nrows; row += NGW) {
        const bool lat = row < MLAT; const int mb = lat ? (row >> 11) : 8;
        const float* xr = (lat ? src_lat + (size_t)row * D : src_ctx + (size_t)(row - MLAT) * D) + 4 * lane;
        f32x4 v[4]; float ss = 0.f;
#pragma unroll
        for (int j = 0; j < 4; ++j) { v[j] = *(const f32x4*)(xr + 256 * j); ss += (v[j].x * v[j].x + v[j].y * v[j].y) + (v[j].z * v[j].z + v[j].w * v[j].w); }
        const float rstd = 1.0f / sqrtf(wave_sum(ss) * (1.0f / D) + RMS_EPS);
        const float* sh = modl + (size_t)mb * NMODC + (3 * s) * D + 4 * lane; const float* scp = sh + D; const float* gp = g + 4 * lane;
        bf16* orow = XN + (size_t)row * D + 4 * lane;
#pragma unroll
        for (int j = 0; j < 4; ++j) { const f32x4 gg = *(const f32x4*)(gp + 256 * j), sc4 = *(const f32x4*)(scp + 256 * j), sh4 = *(const f32x4*)(sh + 256 * j);
            const f32x4 y = v[j] * rstd * gg * (sc4 + 1.0f) + sh4; v2u o; o.x = pk2(y.x, y.y); o.y = pk2(y.z, y.w); *(v2u*)(orow + 256 * j) = o; }
    }
}
__device__ __forceinline__ void final_phase(float* X, const float* g, int wave, int lane) {
    const int gw = blockIdx.x * NWAVES + wave, NGW = gridDim.x * NWAVES;
    for (int row = gw; row < MLAT; row += NGW) {
        float* xr = X + (size_t)row * D + 4 * lane; f32x4 v[4]; float ss = 0.f;
#pragma unroll
        for (int j = 0; j < 4; ++j) { v[j] = *(const f32x4*)(xr + 256 * j); ss += (v[j].x * v[j].x + v[j].y * v[j].y) + (v[j].z * v[j].z + v[j].w * v[j].w); }
        const float rstd = 1.0f / sqrtf(wave_sum(ss) * (1.0f / D) + RMS_EPS);
#pragma unroll
        for (int j = 0; j < 4; ++j) *(f32x4*)(xr + 256 * j) = v[j] * rstd * *(const f32x4*)(g + 4 * lane + 256 * j);
    }
}
__device__ __forceinline__ void convpool_token(const bf16* U, bf16* Y, const float* convw  , int row, int lane) {
    const bool lat = row < MLAT; const int L = lat ? SEQ : CTX; const int t = lat ? (row & (SEQ - 1)) : ((row - MLAT) & (CTX - 1));
    const bf16* ur = U + (size_t)row * UW;
    if (lane < 32) {
        const int ch = 8 * lane; float accv[8];
#pragma unroll
        for (int e = 0; e < 8; ++e) accv[e] = 0.f;
#pragma unroll
        for (int k = 0; k < 3; ++k) { const int tt = t + k - 1; if (tt >= 0 && tt < L) { const bf16* p = ur + (ptrdiff_t)(k - 1) * UW;
                const bf16x8 h8 = *(const bf16x8*)(p + ch), c8 = *(const bf16x8*)(p + 512 + ch); const f32x4 w0 = *(const f32x4*)(convw + k * 256 + ch), w1 = *(const f32x4*)(convw + k * 256 + ch + 4);
#pragma unroll
                for (int e = 0; e < 8; ++e) accv[e] += (e < 4 ? w0[e] : w1[e - 4]) * (bf2f((unsigned short)h8[e]) * bf2f((unsigned short)c8[e])); } }
        const bf16x8 b8 = *(const bf16x8*)(ur + 256 + ch);
        v4u o; o.x = pk2(accv[0] * bf2f((unsigned short)b8[0]), accv[1] * bf2f((unsigned short)b8[1])); o.y = pk2(accv[2] * bf2f((unsigned short)b8[2]), accv[3] * bf2f((unsigned short)b8[3]));
        o.z = pk2(accv[4] * bf2f((unsigned short)b8[4]), accv[5] * bf2f((unsigned short)b8[5])); o.w = pk2(accv[6] * bf2f((unsigned short)b8[6]), accv[7] * bf2f((unsigned short)b8[7]));
        *(v4u*)(Y + (size_t)row * D + ch) = o;
    } else {
        const int pl = lane - 32, ch = 8 * pl, gi = pl >> 3, w = 2 << gi;
        const int lo = max(t - (w >> 1), 0), hi = min(t + (w >> 1), L);
        float sum[8];
#pragma unroll
        for (int e = 0; e < 8; ++e) sum[e] = 0.f;
        for (int tt = lo; tt < hi; ++tt) { const bf16x8 v8 = *(const bf16x8*)(ur + (ptrdiff_t)(tt - t) * UW + 768 + ch);
#pragma unroll
            for (int e = 0; e < 8; ++e) sum[e] += bf2f((unsigned short)v8[e]); }
        const float inv = 1.0f / (float)(hi - lo); const bf16x8 v0 = *(const bf16x8*)(ur + 768 + ch);
        float d[8];
#pragma unroll
        for (int e = 0; e < 8; ++e) d[e] = sum[e] * inv - bf2f((unsigned short)v0[e]);
        v4u o; o.x = pk2(d[0], d[1]); o.y = pk2(d[2], d[3]); o.z = pk2(d[4], d[5]); o.w = pk2(d[6], d[7]);
        *(v4u*)(Y + (size_t)row * D + 256 + ch) = o;
    }
}
__device__ __forceinline__ void attn_item(const bf16* U, const bf16* VTl, const bf16* VTc, bf16* Y, const float* rpbh, int b, int h, int qrow0, int nloc, int nct, int ct0, int rs, int r, int j, int lane) {
    const int kq = lane & 15, quad = lane >> 4;
    const bf16* qp = U + (size_t)(qrow0 + kq) * UW + OFFQ + h * 64 + 8 * quad;
    const bf16x8 q0 = *(const bf16x8*)qp, q1 = *(const bf16x8*)(qp + 32);
    f32x4 o[4];
#pragma unroll
    for (int dt = 0; dt < 4; ++dt) o[dt] = (f32x4){0.f, 0.f, 0.f, 0.f};
    float mrun = -1e30f, lsum = 0.f;
    const int qc = 16 * j + kq; const int cstart = min(max(qc - 8, 0), 48);
    const int ntiles = nloc + 16;
    const bf16* kctx = U + (size_t)(MLAT + b * CTX + kq) * UW + OFFK + h * 64 + 8 * quad;
    const bf16* klat = U + (size_t)(b * SEQ + kq) * UW + OFFK + h * 64 + 8 * quad;
    const bf16* vctx = VTc + ((size_t)(b * 8 + h) * 64 + kq) * CTX + 4 * quad;
    const bf16* vlat = VTl + ((size_t)(b * 8 + h) * 64 + kq) * SEQ + 4 * quad;
    for (int c = 0; c < ntiles; c += 2) {
        const bool loc = c < nloc;
        f32x4 s[2]; s16x4 vf[2][4]; int irow[2], kc0[2];
#pragma unroll
        for (int tt = 0; tt < 2; ++tt) {
            const int tile = c + tt; const bf16* kp; const bf16* vp; int vstride;
            if (loc) { const int ir = tile / nct, ct = ct0 + tile - ir * nct; const int tok0 = (rs + ir) * 64 + 16 * ct; irow[tt] = ir; kc0[tt] = 16 * ct + 4 * quad;
                kp = klat + (size_t)tok0 * UW; vp = vlat + tok0; vstride = SEQ; }
            else { const int tok0 = 16 * (tile - nloc); irow[tt] = 0; kc0[tt] = 0; kp = kctx + (size_t)tok0 * UW; vp = vctx + tok0; vstride = CTX; }
            const bf16x8 k0 = *(const bf16x8*)kp, k1 = *(const bf16x8*)(kp + 32);
#pragma unroll
            for (int dt = 0; dt < 4; ++dt) vf[tt][dt] = *(const s16x4*)(vp + (size_t)(16 * dt) * vstride);
            f32x4 z = (f32x4){0.f, 0.f, 0.f, 0.f};
            z = __builtin_amdgcn_mfma_f32_16x16x32_bf16(k0, q0, z, 0, 0, 0);
            s[tt] = __builtin_amdgcn_mfma_f32_16x16x32_bf16(k1, q1, z, 0, 0, 0);
        }
        if (loc) {
#pragma unroll
            for (int tt = 0; tt < 2; ++tt) { const float* bp = rpbh + (rs + irow[tt] - r + 7) * 31;
#pragma unroll
                for (int i = 0; i < 4; ++i) { const int kc = kc0[tt] + i; const bool valid = (kc >= cstart) && (kc < cstart + 16); const int idx = min(max(kc - qc + 15, 0), 30);
                    const float bias = bp[idx]; s[tt][i] = valid ? s[tt][i] + bias : -1e30f; } }
        }
        float mx = fmaxf(fmaxf(fmaxf(s[0][0], s[0][1]), fmaxf(s[0][2], s[0][3])), fmaxf(fmaxf(s[1][0], s[1][1]), fmaxf(s[1][2], s[1][3])));
        mx = fmaxf(mx, __shfl_xor(mx, 16)); mx = fmaxf(mx, __shfl_xor(mx, 32));
        const float mnew = fmaxf(mrun, mx); const float alpha = __builtin_amdgcn_exp2f((mrun - mnew) * 1.44269504089f); mrun = mnew;
        float p[8]; float ps = 0.f;
#pragma unroll
        for (int i = 0; i < 8; ++i) { p[i] = __builtin_amdgcn_exp2f((s[i >> 2][i & 3] - mnew) * 1.44269504089f); ps += p[i]; }
        lsum = lsum * alpha + ps;
        v4u pb; pb.x = pk2(p[0], p[1]); pb.y = pk2(p[2], p[3]); pb.z = pk2(p[4], p[5]); pb.w = pk2(p[6], p[7]);
        const bf16x8 pfrag = __builtin_bit_cast(bf16x8, pb);
#pragma unroll
        for (int dt = 0; dt < 4; ++dt) { const bf16x8 va = __builtin_shufflevector(vf[0][dt], vf[1][dt], 0, 1, 2, 3, 4, 5, 6, 7);
            o[dt] = __builtin_amdgcn_mfma_f32_16x16x32_bf16(va, pfrag, o[dt] * alpha, 0, 0, 0); }
    }
    lsum += __shfl_xor(lsum, 16); lsum += __shfl_xor(lsum, 32);
    const float inv = 1.0f / lsum;
    bf16* yp = Y + (size_t)(qrow0 + kq) * D + 512 + h * 64 + 4 * quad;
#pragma unroll
    for (int dt = 0; dt < 4; ++dt) { v2u w; w.x = pk2(o[dt][0] * inv, o[dt][1] * inv); w.y = pk2(o[dt][2] * inv, o[dt][3] * inv); *(v2u*)(yp + 16 * dt) = w; }
}
__device__ __forceinline__ void mix_phase(const bf16* U, const bf16* VTl, const bf16* VTc, bf16* Y, const float* rpb  , const float* convw, bool with_ctx, int wave, int lane) {
    const int gw = blockIdx.x * NWAVES + wave, NGW = gridDim.x * NWAVES;
    constexpr int NA = BATCH * 32 * 8 * 4, NC = BATCH * 8 * 16;
    const int nc = with_ctx ? NC : 0, nt = with_ctx ? MT : MLAT, total = NA + nc + nt;
    for (int it = gw; it < total; it += NGW) {
        if (it < NA) { const int j = it & 3, h = (it >> 2) & 7, r = (it >> 5) & 31, b = it >> 10;
            const int rs = min(max(r - 4, 0), 24); const int ct0 = (j == 0) ? 0 : (j == 3 ? 2 : j - 1), nct = (j == 0 || j == 3) ? 2 : 3;
            attn_item(U, VTl, VTc, Y, rpb + h * 465, b, h, b * SEQ + r * 64 + 16 * j, 8 * nct, nct, ct0, rs, r, j, lane);
        } else if (it < NA + nc) { const int x = it - NA; const int qb = x & 15, h = (x >> 4) & 7, b = x >> 7;
            attn_item(U, VTl, VTc, Y, rpb, b, h, MLAT + b * CTX + 16 * qb, 0, 1, 0, 0, 0, 0, lane);
        } else convpool_token(U, Y, convw, it - NA - nc, lane);
    }
}

constexpr int N_STEPS = 22;
__global__ void __launch_bounds__(NTHREADS, 2) fwd(Args a) {
    extern __shared__ __attribute__((aligned(16))) unsigned char lds_raw[];
    LAS unsigned char* lds = (LAS unsigned char*)lds_raw;
    unsigned char* ws = a.ws;
    float* MOD = (float*)(ws + WS_MOD);
    float* Xl = a.out; float* Xc = (float*)(ws + WS_XC);
    bf16* XN = (bf16*)(ws + WS_XN); bf16* Hb = (bf16*)(ws + WS_H); bf16* Ub = (bf16*)(ws + WS_H); bf16* Yb = (bf16*)(ws + WS_Y);
    bf16* VTl = (bf16*)(ws + WS_VTL); bf16* VTc = (bf16*)(ws + WS_VTC);
    for (int st = a.ph_lo; st < a.ph_hi; ++st) {
        int tid_l = threadIdx.x; asm volatile("" : "+v"(tid_l));
        const int tid = tid_l, lane = tid & 63, wave = __builtin_amdgcn_readfirstlane(tid >> 6);
#ifndef NO_PRO
        if (st == 0) prologue(a, lds, tid, wave, lane);
#else
        if (st == 0) {}
#endif
        else if (st == N_STEPS - 1) final_phase(Xl, a.in[I_FINALG], wave, lane);
        else {
            const int l = (st - 1) / 10, k = (st - 1) % 10;
            const float* modl = MOD + (size_t)l * 9 * NMODC;
            unsigned char* wb = ws + WS_W + (size_t)l * W_LAYER;
            const bool first = (l == 0 && k <= 2);
            const float* sl = first ? a.in[I_X] : Xl; const float* sx = first ? a.in[I_CTX] : Xc;
            const int rows = (l == 1 && k >= 5) ? MLAT : MT;
            if (st == 1) wout_transposes(a, lds, wave, lane);
            if (k == 0 || k == 3 || k == 7) { const int s = k == 0 ? 0 : (k == 3 ? 1 : 2);
                norm_phase(sl, sx, XN, a.in[I_NORMG] + (size_t)(l * 3 + s) * D, modl, s, rows, wave, lane);
            } else if (k == 1 || k == 8) {
                pg8::Gemm g{XN, (const bf16*)(wb + (k == 1 ? WO_W1A : WO_W1B)), rows, 2 * DFF, D}; pg8::StaticOrder S; S.init(rows, 2 * DFF, gridDim.x, blockIdx.x);
                pg8::EpiSwiglu E{Hb, DFF};
#ifndef NO_SW
                pg8::gemm_phase<pg8::EpiSwiglu, pg8::StaticOrder, true, true>(lds, g, S, E);
#endif
            } else if (k == 2 || k == 9 || k == 6) {
                const bf16* A = (k == 6) ? Yb : Hb; const bf16* Bt = (const bf16*)(wb + (k == 2 ? WO_W2A : (k == 9 ? WO_W2B : WO_WOUT)));
                const int K = (k == 6) ? D : DFF; const int gi = (k == 2) ? 2 : (k == 6 ? 5 : 8);
                pg8::Gemm g{A, Bt, rows, D, K}; pg8::StaticOrder S; S.init(rows, D, gridDim.x, blockIdx.x);
                pg8::EpiResid E{sl, sx, Xl, Xc, modl + gi * D, (k == 6) ? 1.0f : 0.5f};
#ifndef NO_RS
                pg8::gemm_phase<pg8::EpiResid, pg8::StaticOrder, true, true>(lds, g, S, E);
#endif
            } else if (k == 4) {
                pg8::Gemm g{XN, (const bf16*)(wb + WO_WIN), rows, 2560, D}; pg8::StaticOrder S; S.init(rows, 2560, gridDim.x, blockIdx.x);
                pg8::EpiU E{Ub, VTl, VTc};
#ifndef NO_U
                pg8::gemm_phase<pg8::EpiU, pg8::StaticOrder, true, true>(lds, g, S, E);
#endif
            } else {
#ifndef NO_MIX
                mix_phase(Ub, VTl, VTc, Yb, a.in[I_RPB] + (size_t)l * 8 * 465, a.in[I_CONVW] + (size_t)l * 768, l == 0, wave, lane);
#endif
            }
        }
        if (a.coop && st + 1 < a.ph_hi) cg::this_grid().sync();
    }
}

extern "C" void kernel_launch(void* const* d_in, const int* in_sizes, int n_in, void* d_out, int out_size, void* d_ws, size_t ws_size, hipStream_t stream) {
    static int grid = 0;
    if (grid == 0) {
        if (n_in != 16 || in_sizes[0] != MLAT * D || out_size != MLAT * D || ws_size < WS_END) { fprintf(stderr, "kernel_launch: unexpected shapes (n_in %d, in0 %d, out %d, ws %zu)\n", n_in, n_in > 0 ? in_sizes[0] : -1, out_size, ws_size); grid = -1; return; }
        int dev = 0, cus = 0, per_cu = 0;
        if (hipGetDevice(&dev) != hipSuccess || hipDeviceGetAttribute(&cus, hipDeviceAttributeMultiprocessorCount, dev) != hipSuccess) { grid = -1; return; }
        if (hipFuncSetAttribute((const void*)fwd, hipFuncAttributeMaxDynamicSharedMemorySize, LDS_BYTES) != hipSuccess) { fprintf(stderr, "kernel_launch: hipFuncSetAttribute failed\n"); grid = -1; return; }
        if (hipOccupancyMaxActiveBlocksPerMultiprocessor(&per_cu, (const void*)fwd, NTHREADS, LDS_BYTES) != hipSuccess || per_cu < 1) { fprintf(stderr, "kernel_launch: occupancy query says %d blocks per CU\n", per_cu); grid = -1; (void)hipGetLastError(); return; }
        grid = cus;
    }
    if (grid < 0) return;
    Args a{};
    for (int i = 0; i < 16; ++i) a.in[i] = (const float*)d_in[i];
    a.out = (float*)d_out; a.ws = (unsigned char*)d_ws;
#if MK_COOP
    a.ph_lo = 0; a.ph_hi = N_STEPS; a.coop = 1;
    void* args[] = {&a};
    hipError_t e = hipLaunchCooperativeKernel((const void*)fwd, dim3(grid), dim3(NTHREADS), args, LDS_BYTES, stream);
    if (e != hipSuccess) fprintf(stderr, "kernel_launch: cooperative launch failed: %s (grid %d)\n", hipGetErrorString(e), grid);
#else
    for (int st = 0; st < N_STEPS; ++st) { a.ph_lo = st; a.ph_hi = st + 1; a.coop = 0;
        hipLaunchKernelGGL(fwd, dim3(grid), dim3(NTHREADS), LDS_BYTES, stream, a); }
#endif
}
```

```cpp
#include <hip/hip_runtime.h>
#include <hip/hip_cooperative_groups.h>
#include <cstdio>
#include <cstdint>
namespace cg = cooperative_groups;
#ifndef MK_COOP
#define MK_COOP 1
#endif
#ifndef PROBE_DUP
#define PROBE_DUP 0
#endif
namespace pg8 {
#define PG8_LAS __attribute__((address_space(3)))
typedef unsigned short bf16_t;
typedef short bf16x8 __attribute__((ext_vector_type(8)));
typedef float f32x4 __attribute__((ext_vector_type(4)));
typedef unsigned u32x4 __attribute__((ext_vector_type(4)));
constexpr int BM = 256, BK = 64, HALF = 128, HTB = HALF * BK * 2  , STAGE_BYTES = 8 * HTB, NXCD = 8, WGM = 8;

__host__ __device__ __forceinline__ int lds_byte(int r, int c) { const int st = (r >> 4) * 2 + (c >> 5), rr = r & 15, cc = c & 31, ob = rr * 64 + cc * 2; return st * 1024 + (ob ^ (((ob >> 9) & 1) << 5)); }
__host__ __device__ __forceinline__ void stage_rc(int b, int& R, int& C) { const int st = b / 1024, sb = b % 1024, swz = sb ^ (((sb >> 9) & 1) << 5); R = (st >> 1) * 16 + swz / 64; C = (st & 1) * 32 + (swz % 64) / 2; }
__host__ __device__ __forceinline__ int perm32(int rho) { const int n = rho >> 4, i = rho & 15; return 8 * (i >> 2) + 4 * n + (i & 3); }

struct Unit { int pm, pn; };
struct Gemm { const bf16_t* A; const bf16_t* Bt; int M, N, K; };

struct StaticOrder {
    int nM, nN, nwg, G, c;
    __host__ __device__ void init(int M, int N, int G_, int c_) { nM = M / BM; nN = N / BM; nwg = nM * nN; G = G_; c = c_; }
    __host__ __device__ bool next(int i, Unit& u) const {
        const long L = (long)i * G + c; if (L >= nwg) return false;
        int wgid = (int)L; { const int q = nwg / NXCD, r = nwg % NXCD, xcd = wgid % NXCD, off = wgid / NXCD; wgid = (xcd < r ? xcd * (q + 1) : r * (q + 1) + (xcd - r) * q) + off; }
        const int nig = WGM * nN, gid = wgid / nig, fm = gid * WGM, gsz = (nM - fm) < WGM ? (nM - fm) : WGM;
        u.pm = fm + ((wgid % nig) % gsz); u.pn = (wgid % nig) / gsz; return true;
    }
    __device__ __forceinline__ void a_ready(const Unit&) const {}
    __device__ __forceinline__ void done(const Unit&) const {}
};

__device__ __forceinline__ unsigned cvt_pk_bf16(float lo, float hi) { unsigned r; asm volatile("v_cvt_pk_bf16_f32 %0, %1, %2" : "=v"(r) : "v"(lo), "v"(hi)); return r; }
constexpr int LAT_TILES = 64;
typedef unsigned u32x2 __attribute__((ext_vector_type(2)));
__device__ __forceinline__ float silu_f(float a) { return a * __builtin_amdgcn_rcpf(1.0f + __builtin_amdgcn_exp2f(-1.44269504089f * a)); }
struct EpiSwiglu {
    static constexpr bool PERM = true, AFTER_DRAIN = false;
    bf16_t* H; int ldh;
    __device__ __forceinline__ void operator()(const f32x4 (&acc)[2][2][4][2], const Unit& u, int wr, int wc, int fr, int fq) const {
        const int row0 = u.pm * BM + wr * 64 + fr, col0 = u.pn * HALF + wc * 32 + 8 * fq;
#pragma unroll
        for (int ai = 0; ai < 2; ++ai)
#pragma unroll
            for (int m = 0; m < 4; ++m) { bf16_t* rowp = H + (size_t)(row0 + ai * HALF + m * 16) * ldh + col0;
                const f32x4 a0 = acc[ai][0][m][0], a1 = acc[ai][0][m][1], b0 = acc[ai][1][m][0], b1 = acc[ai][1][m][1];
                u32x4 w; w.x = cvt_pk_bf16(silu_f(a0[0]) * b0[0], silu_f(a0[1]) * b0[1]); w.y = cvt_pk_bf16(silu_f(a0[2]) * b0[2], silu_f(a0[3]) * b0[3]);
                w.z = cvt_pk_bf16(silu_f(a1[0]) * b1[0], silu_f(a1[1]) * b1[1]); w.w = cvt_pk_bf16(silu_f(a1[2]) * b1[2], silu_f(a1[3]) * b1[3]);
                *(u32x4*)rowp = w; }
    }
};
struct EpiResid {
    static constexpr bool PERM = false, AFTER_DRAIN = false;
    const float* base_lat; const float* base_ctx; float* out_lat; float* out_ctx; const float* gate; float coef;
    __device__ __forceinline__ void operator()(const f32x4 (&acc)[2][2][4][2], const Unit& u, int wr, int wc, int fr, int fq) const {
        const bool lat = u.pm < LAT_TILES; const int mb = lat ? (u.pm >> 3) : 8;
        const size_t toff = (size_t)(lat ? u.pm : u.pm - LAT_TILES) * BM * 1024;
        const float* bp = (lat ? base_lat : base_ctx) + toff; float* op = (lat ? out_lat : out_ctx) + toff;
        const int col0 = u.pn * BM + wc * 32 + 4 * fq; const float* g = gate + (size_t)mb * 9216 + col0;
        f32x4 gv[2][2];
#pragma unroll
        for (int bj = 0; bj < 2; ++bj)
#pragma unroll
            for (int n = 0; n < 2; ++n) gv[bj][n] = *(const f32x4*)(g + bj * HALF + n * 16) * coef;
#pragma unroll
        for (int ai = 0; ai < 2; ++ai)
#pragma unroll
            for (int m = 0; m < 4; ++m) { const size_t off = (size_t)(ai * HALF + wr * 64 + m * 16 + fr) * 1024 + col0;
#pragma unroll
                for (int bj = 0; bj < 2; ++bj)
#pragma unroll
                    for (int n = 0; n < 2; ++n) { const f32x4 bs = *(const f32x4*)(bp + off + bj * HALF + n * 16);
                        *(f32x4*)(op + off + bj * HALF + n * 16) = bs + gv[bj][n] * acc[ai][bj][m][n]; } }
    }
};
struct EpiU {
    static constexpr bool PERM = true, AFTER_DRAIN = false;
    bf16_t* U; bf16_t* QP; bf16_t* KP; bf16_t* VP;
    __device__ __forceinline__ void operator()(const f32x4 (&acc)[2][2][4][2], const Unit& u, int wr, int wc, int fr, int fq) const {
        if (u.pn < 4) {
            const int row0 = u.pm * BM + wr * 64 + fr, col0 = u.pn * BM + wc * 32 + 8 * fq;
#pragma unroll
            for (int ai = 0; ai < 2; ++ai)
#pragma unroll
                for (int m = 0; m < 4; ++m) { bf16_t* rowp = U + (size_t)(row0 + ai * HALF + m * 16) * 1024 + col0;
#pragma unroll
                    for (int bj = 0; bj < 2; ++bj) { const f32x4 v0 = acc[ai][bj][m][0], v1 = acc[ai][bj][m][1];
                        u32x4 w; w.x = cvt_pk_bf16(v0[0], v0[1]); w.y = cvt_pk_bf16(v0[2], v0[3]); w.z = cvt_pk_bf16(v1[0], v1[1]); w.w = cvt_pk_bf16(v1[2], v1[3]);
                        *(u32x4*)(rowp + bj * HALF) = w; } }
        } else if (u.pn < 8) {
            const float sc = (u.pn < 6) ? 0.18033688011112042f : 1.0f;
            bf16_t* P = (u.pn < 6) ? QP : KP;
            const int t16b = (u.pm * BM + wr * 64) >> 4;
#pragma unroll
            for (int ai = 0; ai < 2; ++ai)
#pragma unroll
                for (int m = 0; m < 4; ++m)
#pragma unroll
                    for (int bj = 0; bj < 2; ++bj) { const int h = 4 * (u.pn & 1) + 2 * bj + (wc >> 1);
                        bf16_t* p = P + ((size_t)(t16b + 8 * ai + m) * 8 + h) * 1024 + (((wc & 1) * 4 + fq) * 16 + fr) * 8;
                        const f32x4 v0 = acc[ai][bj][m][0] * sc, v1 = acc[ai][bj][m][1] * sc;
                        u32x4 w; w.x = cvt_pk_bf16(v0[0], v0[1]); w.y = cvt_pk_bf16(v0[2], v0[3]); w.z = cvt_pk_bf16(v1[0], v1[1]); w.w = cvt_pk_bf16(v1[2], v1[3]);
                        *(u32x4*)p = w; }
        } else {
            const int t32b = (u.pm * BM + wr * 64) >> 5;
            const int dt = 2 * (wc & 1) + (fq >> 1);
#pragma unroll
            for (int ai = 0; ai < 2; ++ai)
#pragma unroll
                for (int m = 0; m < 4; ++m)
#pragma unroll
                    for (int bj = 0; bj < 2; ++bj) { const int h = 4 * (u.pn - 8) + 2 * bj + (wc >> 1);
                        bf16_t* blk = VP + ((size_t)(t32b + 4 * ai + (m >> 1)) * 8 + h) * 2048 + (m & 1) * 4 + (fr & 3);
#pragma unroll
                        for (int n = 0; n < 2; ++n) { const f32x4 v = acc[ai][bj][m][n]; const int kq0 = 8 * (fq & 1) + 4 * n;
                            bf16_t* p = blk + ((dt * 64 + (fr >> 2) * 16 + kq0) * 8);
                            const unsigned w0 = cvt_pk_bf16(v[0], v[1]), w1 = cvt_pk_bf16(v[2], v[3]);
                            p[0] = (bf16_t)(w0 & 0xffffu); p[8] = (bf16_t)(w0 >> 16); p[16] = (bf16_t)(w1 & 0xffffu); p[24] = (bf16_t)(w1 >> 16); } }
        }
    }
};
template <class Epi, class Sched, bool ALIGN_EPI = false, bool SP2 = false>
__device__ __forceinline__ void gemm_phase(PG8_LAS unsigned char* lds, const Gemm g, const Sched& S, const Epi& E) {
    int tid_l = threadIdx.x; asm volatile("" : "+v"(tid_l));
    const int tid = tid_l, wid = __builtin_amdgcn_readfirstlane(tid >> 6), lane = tid & 63, wr = wid >> 2, wc = wid & 3, fr = lane & 15, fq = lane >> 4;
    const int K = g.K, nt = K / BK;
    unsigned voffA[2], voffB[2];
#pragma unroll
    for (int i = 0; i < 2; ++i) { int R, C; stage_rc(tid * 16 + i * 8192, R, C); const int Rb = Epi::PERM ? ((R & ~31) + perm32(R & 31)) : R;
        voffA[i] = (unsigned)(R * K + C) * 2u; voffB[i] = (unsigned)(Rb * K + C) * 2u; }
    const size_t kstep = (size_t)(BK * 2);
    const size_t hstep = (size_t)HALF * K * 2;
    const size_t tstep = 2 * hstep;
    const unsigned ldsw = (unsigned)wid * 1024u;
    const int aoff = lds_byte(wr * 64 + fr, fq * 8), boff = lds_byte(wc * 32 + fr, fq * 8);
#define PG8_SA(b, h) (((b) * 2 + (h)) * HTB)
#define PG8_SB(b, h) ((4 + (b) * 2 + (h)) * HTB)
#define PG8_STAGE(bufoff, gbase, voff) do { _Pragma("unroll") for (int _i = 0; _i < 2; ++_i) \
        __builtin_amdgcn_global_load_lds((const unsigned*)((const char*)(gbase) + (voff)[_i]), (PG8_LAS unsigned*)(lds + (bufoff) + ldsw + _i * 8192), 16, 0, 0); } while (0)
#define PG8_LDA(dst, b, h) do { _Pragma("unroll") for (int m = 0; m < 4; ++m) _Pragma("unroll") for (int k = 0; k < 2; ++k) dst[m][k] = *(const PG8_LAS bf16x8*)(lds + PG8_SA(b, h) + aoff + m * 2048 + k * 1024); } while (0)
#define PG8_LDB(dst, b, h) do { _Pragma("unroll") for (int n = 0; n < 2; ++n) _Pragma("unroll") for (int k = 0; k < 2; ++k) dst[n][k] = *(const PG8_LAS bf16x8*)(lds + PG8_SB(b, h) + boff + n * 2048 + k * 1024); } while (0)
#define PG8_MMA(ai, bj, At, Bt) do { __builtin_amdgcn_s_setprio(1); _Pragma("unroll") for (int m = 0; m < 4; ++m) _Pragma("unroll") for (int n = 0; n < 2; ++n) _Pragma("unroll") for (int k = 0; k < 2; ++k) \
        acc[ai][bj][m][n] = __builtin_amdgcn_mfma_f32_16x16x32_bf16(Bt[n][k], At[m][k], acc[ai][bj][m][n], 0, 0, 0); __builtin_amdgcn_s_setprio(0); } while (0)
#define PG8_WAIT_V(n) asm volatile("s_waitcnt vmcnt(" #n ")" ::: "memory")
#define PG8_WAIT_L(n) asm volatile("s_waitcnt lgkmcnt(" #n ")" ::: "memory")
#define PG8_BAR __builtin_amdgcn_s_barrier()
#define PG8_SCHED __builtin_amdgcn_sched_barrier(0)
    Unit cur, nxt; int ui = 0;
    if (!S.next(0, cur)) return;
    f32x4 acc[2][2][4][2];
#pragma unroll
    for (int a = 0; a < 2; ++a)
#pragma unroll
        for (int b = 0; b < 2; ++b)
#pragma unroll
            for (int m = 0; m < 4; ++m)
#pragma unroll
                for (int n = 0; n < 2; ++n) acc[a][b][m][n] = (f32x4){0.f, 0.f, 0.f, 0.f};
    bf16x8 At[4][2], B0[2][2], B1[2][2];
    const char* cA = (const char*)g.A + (size_t)cur.pm * tstep; const char* cB = (const char*)g.Bt + (size_t)cur.pn * tstep;
    S.a_ready(cur);
    if constexpr (SP2) {
        PG8_STAGE(PG8_SB(0, 0), cB, voffB); PG8_STAGE(PG8_SB(0, 1), cB + hstep, voffB); PG8_STAGE(PG8_SA(0, 0), cA, voffA); PG8_STAGE(PG8_SA(0, 1), cA + hstep, voffA);
        if (wr == 1) PG8_BAR;
        PG8_WAIT_V(2); PG8_BAR;
        PG8_STAGE(PG8_SB(1, 0), cB + kstep, voffB); PG8_STAGE(PG8_SA(1, 0), cA + kstep, voffA); PG8_STAGE(PG8_SB(1, 1), cB + hstep + kstep, voffB);
        PG8_WAIT_V(6); PG8_BAR;
    } else {
        PG8_STAGE(PG8_SB(0, 0), cB, voffB); PG8_STAGE(PG8_SA(0, 0), cA, voffA); PG8_STAGE(PG8_SB(0, 1), cB + hstep, voffB); PG8_STAGE(PG8_SA(0, 1), cA + hstep, voffA);
        if (wr == 1) PG8_BAR;
        PG8_WAIT_V(4); PG8_BAR;
        PG8_STAGE(PG8_SB(1, 0), cB + kstep, voffB); PG8_STAGE(PG8_SA(1, 0), cA + kstep, voffA); PG8_STAGE(PG8_SB(1, 1), cB + hstep + kstep, voffB);
        PG8_WAIT_V(6); PG8_BAR;
    }
    for (;;) {
        const bool has_next = S.next(ui + 1, nxt);
        const char* nA = has_next ? (const char*)g.A + (size_t)nxt.pm * tstep : cA; const char* nB = has_next ? (const char*)g.Bt + (size_t)nxt.pn * tstep : cB;
        for (int t = 0; t < nt; t += 2) {
            const bool last = (t == nt - 2);
            const char* a1 = cA + (size_t)(t + 1) * kstep;
            const char* a2 = last ? nA : cA + (size_t)(t + 2) * kstep; const char* b2 = last ? nB : cB + (size_t)(t + 2) * kstep;
            const char* a3 = a2 + kstep; const char* b3 = b2 + kstep;
            if (last && has_next) S.a_ready(nxt);
            if constexpr (SP2) {
            PG8_LDB(B0, 0, 0); PG8_LDB(B1, 0, 1); PG8_SCHED; PG8_LDA(At, 0, 0); PG8_STAGE(PG8_SA(1, 1), a1 + hstep, voffA);
            PG8_WAIT_V(8); PG8_WAIT_L(0); PG8_BAR; PG8_MMA(0, 0, At, B0); PG8_MMA(0, 1, At, B1); PG8_BAR; PG8_SCHED;
            PG8_LDA(At, 0, 1); PG8_STAGE(PG8_SB(0, 0), b2, voffB); PG8_STAGE(PG8_SB(0, 1), b2 + hstep, voffB); PG8_STAGE(PG8_SA(0, 0), a2, voffA);
            PG8_WAIT_V(8); PG8_WAIT_L(0); PG8_BAR; PG8_MMA(1, 0, At, B0); PG8_MMA(1, 1, At, B1); PG8_BAR; PG8_SCHED;
            PG8_LDB(B0, 1, 0); PG8_LDB(B1, 1, 1); PG8_SCHED; PG8_LDA(At, 1, 0); PG8_STAGE(PG8_SA(0, 1), a2 + hstep, voffA);
            PG8_WAIT_V(8); PG8_WAIT_L(0); PG8_BAR; PG8_MMA(0, 0, At, B0); PG8_MMA(0, 1, At, B1); PG8_BAR; PG8_SCHED;
            PG8_LDA(At, 1, 1); PG8_STAGE(PG8_SB(1, 0), b3, voffB); PG8_STAGE(PG8_SB(1, 1), b3 + hstep, voffB); PG8_STAGE(PG8_SA(1, 0), a3, voffA);
            PG8_WAIT_V(8); PG8_WAIT_L(0); PG8_BAR; PG8_MMA(1, 0, At, B0); PG8_MMA(1, 1, At, B1); PG8_BAR; PG8_SCHED;
            } else {
            PG8_LDB(B0, 0, 0); PG8_SCHED; PG8_LDA(At, 0, 0); PG8_STAGE(PG8_SA(1, 1), a1 + hstep, voffA);
            PG8_WAIT_L(8); PG8_BAR; PG8_WAIT_L(0); PG8_MMA(0, 0, At, B0); PG8_BAR; PG8_SCHED;
            PG8_LDB(B1, 0, 1); PG8_STAGE(PG8_SB(0, 0), b2, voffB);
            PG8_BAR; PG8_WAIT_L(0); PG8_MMA(0, 1, At, B1); PG8_BAR;
            PG8_LDA(At, 0, 1); PG8_STAGE(PG8_SA(0, 0), a2, voffA);
            PG8_BAR; PG8_WAIT_L(0); PG8_MMA(1, 0, At, B0); PG8_BAR; PG8_SCHED;
            PG8_STAGE(PG8_SB(0, 1), b2 + hstep, voffB);
            PG8_WAIT_V(6); PG8_BAR; PG8_MMA(1, 1, At, B1); PG8_BAR;
            PG8_LDB(B0, 1, 0); PG8_SCHED; PG8_LDA(At, 1, 0); PG8_STAGE(PG8_SA(0, 1), a2 + hstep, voffA);
            PG8_WAIT_L(8); PG8_BAR; PG8_WAIT_L(0); PG8_MMA(0, 0, At, B0); PG8_BAR; PG8_SCHED;
            PG8_LDB(B1, 1, 1); PG8_STAGE(PG8_SB(1, 0), b3, voffB);
            PG8_BAR; PG8_WAIT_L(0); PG8_MMA(0, 1, At, B1); PG8_BAR;
            PG8_LDA(At, 1, 1); PG8_STAGE(PG8_SA(1, 0), a3, voffA);
            PG8_BAR; PG8_WAIT_L(0); PG8_MMA(1, 0, At, B0); PG8_BAR; PG8_SCHED;
            PG8_STAGE(PG8_SB(1, 1), b3 + hstep, voffB);
            PG8_WAIT_V(6); PG8_BAR; PG8_MMA(1, 1, At, B1); PG8_BAR;
            }
        }
        if constexpr (ALIGN_EPI) { if (wr == 0) PG8_BAR; }
        if constexpr (!Epi::AFTER_DRAIN) { E(acc, cur, wr, wc, fr, fq); S.done(cur); }
        if (!has_next) break;
#pragma unroll
        for (int a = 0; a < 2; ++a)
#pragma unroll
            for (int b = 0; b < 2; ++b)
#pragma unroll
                for (int m = 0; m < 4; ++m)
#pragma unroll
                    for (int n = 0; n < 2; ++n) acc[a][b][m][n] = (f32x4){0.f, 0.f, 0.f, 0.f};
        cur = nxt; cA = nA; cB = nB; ++ui;
        if constexpr (ALIGN_EPI) { if (wr == 1) PG8_BAR; }
    }
    PG8_WAIT_V(0);
    if constexpr (!ALIGN_EPI) { if (wr == 0) PG8_BAR; }
    PG8_BAR;
    if constexpr (Epi::AFTER_DRAIN) { E.fused(acc, cur, wr, wc, fr, fq, lds, wid, lane); S.done(cur); }
#undef PG8_SA
#undef PG8_SB
#undef PG8_STAGE
#undef PG8_LDA
#undef PG8_LDB
#undef PG8_MMA
#undef PG8_WAIT_V
#undef PG8_WAIT_L
#undef PG8_BAR
#undef PG8_SCHED
}
}

#define GAS __attribute__((address_space(1)))
#define LAS __attribute__((address_space(3)))
typedef unsigned short bf16;
typedef unsigned v4u __attribute__((ext_vector_type(4)));
typedef unsigned v2u __attribute__((ext_vector_type(2)));
typedef float f32x4 __attribute__((ext_vector_type(4)));
typedef float f32x2 __attribute__((ext_vector_type(2)));
typedef short bf16x8 __attribute__((ext_vector_type(8)));
typedef short s16x4 __attribute__((ext_vector_type(4)));
typedef __bf16 bf16x2v __attribute__((ext_vector_type(2)));
__device__ __forceinline__ unsigned pk2(float lo, float hi) { return __builtin_bit_cast(unsigned, __builtin_convertvector((f32x2){lo, hi}, bf16x2v)); }
__device__ __forceinline__ float bf2f(unsigned short h) { return __builtin_bit_cast(float, (unsigned)h << 16); }
#define LDS_WAIT() asm volatile("s_waitcnt lgkmcnt(0)" ::: "memory")
typedef GAS unsigned gu32;

constexpr int NWAVES = 8, NTHREADS = 512;
constexpr int D = 1024, BATCH = 8, SEQ = 2048, CTX = 256, DFF = 2816, NMODC = 9216;
constexpr int MLAT = BATCH * SEQ, MCTX = BATCH * CTX, MT = MLAT + MCTX;
constexpr float RMS_EPS = 1e-6f;
constexpr int UW = 1024;
constexpr size_t MiB = 1u << 20;
constexpr size_t WS_MOD = 1 * MiB;
constexpr size_t WS_W = 2 * MiB, W_LAYER = 40 * MiB;
constexpr size_t WO_W1A = 0, WO_W2A = 11 * MiB, WO_WIN = 11 * MiB + 5632 * 1024, WO_WOUT = WO_WIN + 5 * MiB, WO_W1B = WO_WOUT + 2 * MiB, WO_W2B = WO_W1B + 11 * MiB;
static_assert(WO_W2B + 5632 * 1024 == W_LAYER, "weights map");
constexpr size_t WS_WF = 315 * MiB;
constexpr size_t WS_XC = 82 * MiB;
constexpr size_t WS_XN = 90 * MiB;
constexpr size_t WS_H = 126 * MiB;
constexpr size_t WS_Y = 225 * MiB;
constexpr size_t WS_QP = 261 * MiB, WS_KP = 279 * MiB, WS_VP = 297 * MiB, WS_END = 317 * MiB;
constexpr size_t WS_CTL = 0, CTL_ZERO_BYTES = 65536;
constexpr int MISC_OFF = 131072;
constexpr int LDS_BYTES = 131072 + 1024;

struct Args { const float* in[16]; float* out; unsigned char* ws; int ph_lo, ph_hi, coop, pad; };
enum { I_X = 0, I_C, I_CTX, I_CCTX, I_WMOD, I_BMOD, I_NORMG, I_FWIN, I_FWOUT, I_WIN, I_CONVW, I_POOLW, I_POOLS, I_RPB, I_WOUT, I_FINALG };

__device__ __forceinline__ float wave_sum(float v) {
#pragma unroll
    for (int o = 1; o < 64; o <<= 1) v += __shfl_xor(v, o);
    return v;
}

__device__ __forceinline__ void mod_gemv_item(const Args& a, LAS unsigned char* lds, int item, int tid, int wave, int lane) {
    const int l = item / 36, chunk = item % 36;
    LAS float* sc = (LAS float*)lds;
    LAS float* red = (LAS float*)(lds + 40960);
    const float* c = a.in[I_C]; const float* cc = a.in[I_CCTX];
    for (int i = tid; i < 9 * 1024; i += NTHREADS) { const int mb = i >> 10, k = i & 1023; const float v = mb < 8 ? c[mb * 1024 + k] : cc[k]; sc[i] = v / (1.0f + __expf(-v)); }
    __syncthreads();
    const float* W = a.in[I_WMOD] + (size_t)l * 1024 * NMODC + 256 * chunk + 4 * lane;
    f32x4 acc[9];
#pragma unroll
    for (int mb = 0; mb < 9; ++mb) acc[mb] = (f32x4){0.f, 0.f, 0.f, 0.f};
    const int k0 = wave * 128;
#pragma unroll 2
    for (int kk = 0; kk < 128; kk += 4) {
        const f32x4 w0 = *(const f32x4*)(W + (size_t)(k0 + kk) * NMODC), w1 = *(const f32x4*)(W + (size_t)(k0 + kk + 1) * NMODC),
                    w2 = *(const f32x4*)(W + (size_t)(k0 + kk + 2) * NMODC), w3 = *(const f32x4*)(W + (size_t)(k0 + kk + 3) * NMODC);
#pragma unroll
        for (int mb = 0; mb < 9; ++mb) { const f32x4 s4 = *(const LAS f32x4*)(sc + mb * 1024 + k0 + kk); acc[mb] += w0 * s4.x + w1 * s4.y + w2 * s4.z + w3 * s4.w; }
    }
#pragma unroll
    for (int mb = 0; mb < 9; ++mb) *(LAS f32x4*)(red + (wave * 9 + mb) * 256 + 4 * lane) = acc[mb];
    __syncthreads();
    float* MOD = (float*)(a.ws + WS_MOD);
    for (int o = tid; o < 9 * 256; o += NTHREADS) { const int mb = o >> 8, col = o & 255; float s = a.in[I_BMOD][l * NMODC + 256 * chunk + col];
#pragma unroll
        for (int w = 0; w < 8; ++w) s += red[(w * 9 + mb) * 256 + col];
        MOD[(size_t)(l * 9 + mb) * NMODC + 256 * chunk + col] = s; }
    __syncthreads();
}
__device__ __forceinline__ void transpose_item(const float* W, int K, int N, bf16* WT, int kind, const float* pw, const float* ps, LAS float* scr, int item, int lane) {
    const int nblk = N / 32, kb = item / nblk, nb = item % nblk, k0 = 64 * kb, n0 = 32 * nb;
    int drow = n0;
    if (kind == 1) { drow = n0 < DFF ? 256 * (n0 / 128) + (n0 % 128) : 256 * ((n0 - DFF) / 128) + 128 + ((n0 - DFF) % 128); }
    if (kind == 2 && kb >= 4 && kb < 8) {
#pragma unroll 8
        for (int i = 0; i < 32; ++i) { const int kk = 2 * i + (lane >> 5); scr[kk * 33 + (lane & 31)] = pw[(size_t)(k0 - 256 + kk) * N + n0 + (lane & 31)]; }
    } else {
#pragma unroll 8
        for (int i = 0; i < 32; ++i) { const int kk = 2 * i + (lane >> 5); scr[kk * 33 + (lane & 31)] = W[(size_t)(k0 + kk) * N + n0 + (lane & 31)]; }
    }
    LDS_WAIT(); asm volatile("" ::: "memory");
    const int c = lane & 7;
#pragma unroll
    for (int j = 0; j < 4; ++j) { const int n = (lane >> 3) + 8 * j; const LAS float* s = scr + (8 * c) * 33 + n;
        v4u o; o.x = pk2(s[0 * 33], s[1 * 33]); o.y = pk2(s[2 * 33], s[3 * 33]); o.z = pk2(s[4 * 33], s[5 * 33]); o.w = pk2(s[6 * 33], s[7 * 33]);
        *(v4u*)(WT + (size_t)(drow + n) * K + k0 + 8 * c) = o; }
    LDS_WAIT(); asm volatile("" ::: "memory");
}
__device__ __forceinline__ void prologue(const Args& a, LAS unsigned char* lds, int tid, int wave, int lane) {
    if ((int)blockIdx.x < 72) mod_gemv_item(a, lds, blockIdx.x, tid, wave, lane);
    LAS float* scr = (LAS float*)(lds + wave * 16384);
    const int gw = blockIdx.x * NWAVES + wave, NGW = gridDim.x * NWAVES;
    constexpr int I1 = 16 * 176, I2 = 44 * 32, I3 = 16 * 80, PER_L = 2 * I1 + 2 * I2 + I3;
    for (int it = gw; it < 2 * PER_L; it += NGW) {
        const int l = it / PER_L; int r = it % PER_L;
        unsigned char* wb = a.ws + WS_W + (size_t)l * W_LAYER;
        const float* fwin = a.in[I_FWIN] + (size_t)l * 2 * D * 2 * DFF; const float* fwout = a.in[I_FWOUT] + (size_t)l * 2 * DFF * D;
        if (r < I1) { transpose_item(fwin, D, 2 * DFF, (bf16*)(wb + WO_W1A), 1, nullptr, nullptr, scr, r, lane); continue; } r -= I1;
        if (r < I2) { transpose_item(fwout, DFF, D, (bf16*)(wb + WO_W2A), 0, nullptr, nullptr, scr, r, lane); continue; } r -= I2;
        if (r < I3) { transpose_item(a.in[I_WIN] + (size_t)l * D * 2560, D, 2560, (bf16*)(wb + WO_WIN), 0, nullptr, nullptr, scr, r, lane); continue; } r -= I3;
        if (r < I1) { transpose_item(fwin + (size_t)D * 2 * DFF, D, 2 * DFF, (bf16*)(wb + WO_W1B), 1, nullptr, nullptr, scr, r, lane); continue; } r -= I1;
        transpose_item(fwout + (size_t)DFF * D, DFF, D, (bf16*)(wb + WO_W2B), 0, nullptr, nullptr, scr, r, lane);
    }
    float* Wf = (float*)(a.ws + WS_WF);
    for (int it = gw; it < 2 * 256 * 16; it += NGW) {
        const int l = it >> 12, row = (it >> 4) & 255, n = (it & 15) * 64 + lane, g = row >> 6;
        const float* p = a.in[I_POOLW] + ((size_t)l * 256 + row) * 64; const float* ps = a.in[I_POOLS] + l * 256 + 64 * g;
        const float* w = a.in[I_WOUT] + (size_t)l * D * D + (size_t)(256 + 64 * g) * D + n; float sacc = 0.f;
#pragma unroll 8
        for (int j = 0; j < 64; ++j) sacc += p[j] * ps[j] * w[(size_t)j * D];
        Wf[((size_t)l * 256 + row) * D + n] = sacc;
    }
}
__device__ __forceinline__ void wout_transposes(const Args& a, LAS unsigned char* lds, int wave, int lane) {
    LAS float* scr = (LAS float*)(lds + wave * 16384);
    const int gw = blockIdx.x * NWAVES + wave, NGW = gridDim.x * NWAVES;
    for (int it = gw; it < 2 * 512; it += NGW) { const int l = it >> 9;
        transpose_item(a.in[I_WOUT] + (size_t)l * D * D, D, D, (bf16*)(a.ws + WS_W + (size_t)l * W_LAYER + WO_WOUT), 2, (const float*)(a.ws + WS_WF) + (size_t)l * 256 * D, nullptr, scr, it & 511, lane); }
}
__device__ __forceinline__ void norm_phase(const float* src_lat, const float* src_ctx, bf16* XN, const float* g, const float* modl  , int s, int nrows, int wave, int lane) {
    const int gw = blockIdx.x * NWAVES + wave, NGW = gridDim.x * NWAVES;
    for (int row = gw; row < nrows; row += NGW) {
        const bool lat = row < MLAT; const int mb = lat ? (row >> 11) : 8;
        const float* xr = (lat ? src_lat + (size_t)row * D : src_ctx + (size_t)(row - MLAT) * D) + 4 * lane;
        f32x4 v[4]; float ss = 0.f;
#pragma unroll
        for (int j = 0; j < 4; ++j) { v[j] = *(const f32x4*)(xr + 256 * j); ss += (v[j].x * v[j].x + v[j].y * v[j].y) + (v[j].z * v[j].z + v[j].w * v[j].w); }
        const float rstd = 1.0f / sqrtf(wave_sum(ss) * (1.0f / D) + RMS_EPS);
        const float* sh = modl + (size_t)mb * NMODC + (3 * s) * D + 4 * lane; const float* scp = sh + D; const float* gp = g + 4 * lane;
        bf16* orow = XN + (size_t)row * D + 4 * lane;
#pragma unroll
        for (int j = 0; j < 4; ++j) { const f32x4 gg = *(const f32x4*)(gp + 256 * j), sc4 = *(const f32x4*)(scp + 256 * j), sh4 = *(const f32x4*)(sh + 256 * j);
            const f32x4 y = v[j] * rstd * gg * (sc4 + 1.0f) + sh4; v2u o; o.x = pk2(y.x, y.y); o.y = pk2(y.z, y.w); *(v2u*)(orow + 256 * j) = o; }
    }
}
__device__ __forceinline__ void final_phase(float* X, const float* g, int wave, int lane) {
    const int gw = blockIdx.x * NWAVES + wave, NGW = gridDim.x * NWAVES;
    for (int row = gw; row < MLAT; row += NGW) {
        float* xr = X + (size_t)row * D + 4 * lane; f32x4 v[4]; float ss = 0.f;
#pragma unroll
        for (int j = 0; j < 4; ++j) { v[j] = *(const f32x4*)(xr + 256 * j); ss += (v[j].x * v[j].x + v[j].y * v[j].y) + (v[j].z * v[j].z + v[j].w * v[j].w); }
        const float rstd = 1.0f / sqrtf(wave_sum(ss) * (1.0f / D) + RMS_EPS);
#pragma unroll
        for (int j = 0; j < 4; ++j) *(f32x4*)(xr + 256 * j) = v[j] * rstd * *(const f32x4*)(g + 4 * lane + 256 * j);
    }
}
__device__ __forceinline__ void convpool_token(const bf16* U, bf16* Y, const float* convw  , int row, int lane) {
    const bool lat = row < MLAT; const int L = lat ? SEQ : CTX; const int t = lat ? (row & (SEQ - 1)) : ((row - MLAT) & (CTX - 1));
    const bf16* ur = U + (size_t)row * UW;
    if (lane < 32) {
        const int ch = 8 * lane; float accv[8];
#pragma unroll
        for (int e = 0; e < 8; ++e) accv[e] = 0.f;
#pragma unroll
        for (int k = 0; k < 3; ++k) { const int tt = t + k - 1; if (tt >= 0 && tt < L) { const bf16* p = ur + (ptrdiff_t)(k - 1) * UW;
                const bf16x8 h8 = *(const bf16x8*)(p + ch), c8 = *(const bf16x8*)(p + 512 + ch); const f32x4 w0 = *(const f32x4*)(convw + k * 256 + ch), w1 = *(const f32x4*)(convw + k * 256 + ch + 4);
#pragma unroll
                for (int e = 0; e < 8; ++e) accv[e] += (e < 4 ? w0[e] : w1[e - 4]) * (bf2f((unsigned short)h8[e]) * bf2f((unsigned short)c8[e])); } }
        const bf16x8 b8 = *(const bf16x8*)(ur + 256 + ch);
        v4u o; o.x = pk2(accv[0] * bf2f((unsigned short)b8[0]), accv[1] * bf2f((unsigned short)b8[1])); o.y = pk2(accv[2] * bf2f((unsigned short)b8[2]), accv[3] * bf2f((unsigned short)b8[3]));
        o.z = pk2(accv[4] * bf2f((unsigned short)b8[4]), accv[5] * bf2f((unsigned short)b8[5])); o.w = pk2(accv[6] * bf2f((unsigned short)b8[6]), accv[7] * bf2f((unsigned short)b8[7]));
        *(v4u*)(Y + (size_t)row * D + ch) = o;
    } else {
        const int pl = lane - 32, ch = 8 * pl, gi = pl >> 3, w = 2 << gi;
        const int lo = max(t - (w >> 1), 0), hi = min(t + (w >> 1), L);
        float sum[8];
#pragma unroll
        for (int e = 0; e < 8; ++e) sum[e] = 0.f;
        for (int tt = lo; tt < hi; ++tt) { const bf16x8 v8 = *(const bf16x8*)(ur + (ptrdiff_t)(tt - t) * UW + 768 + ch);
#pragma unroll
            for (int e = 0; e < 8; ++e) sum[e] += bf2f((unsigned short)v8[e]); }
        const float inv = 1.0f / (float)(hi - lo); const bf16x8 v0 = *(const bf16x8*)(ur + 768 + ch);
        float d[8];
#pragma unroll
        for (int e = 0; e < 8; ++e) d[e] = sum[e] * inv - bf2f((unsigned short)v0[e]);
        v4u o; o.x = pk2(d[0], d[1]); o.y = pk2(d[2], d[3]); o.z = pk2(d[4], d[5]); o.w = pk2(d[6], d[7]);
        *(v4u*)(Y + (size_t)row * D + 256 + ch) = o;
    }
}
__device__ __forceinline__ float xmax16(float x) { float a = x, b = x; asm volatile("s_nop 1\n\tv_permlane16_swap_b32 %0, %1" : "+v"(a), "+v"(b)); return fmaxf(a, b); }
__device__ __forceinline__ float xmax32(float x) { float a = x, b = x; asm volatile("s_nop 1\n\tv_permlane32_swap_b32 %0, %1" : "+v"(a), "+v"(b)); return fmaxf(a, b); }
struct KV { bf16x8 k[4]; bf16x8 v[4]; };
__device__ __forceinline__ void kv_load(KV& f, const bf16* KP, const bf16* VP, int t32, int h, int lane) {
    const bf16* kp = KP + ((size_t)(2 * t32) * 8 + h) * 1024 + lane * 8; const bf16* vp = VP + ((size_t)t32 * 8 + h) * 2048 + lane * 8;
    f.k[0] = *(const bf16x8*)kp; f.k[1] = *(const bf16x8*)(kp + 512); f.k[2] = *(const bf16x8*)(kp + 8192); f.k[3] = *(const bf16x8*)(kp + 8192 + 512);
#pragma unroll
    for (int dt = 0; dt < 4; ++dt) f.v[dt] = *(const bf16x8*)(vp + dt * 512);
}
template <int JMASK, bool LOCAL>
__device__ __forceinline__ void attn_chunk(const KV& f, const LAS bf16* q, f32x4 (&o)[16], float (&mr)[4], float (&lr)[4], const LAS float* brow, int kc0, int kq) {
#pragma unroll
    for (int j = 0; j < 4; ++j) if (JMASK & (1 << j)) {
        const f32x4 z = (f32x4){0.f, 0.f, 0.f, 0.f};
        const bf16x8 q0 = *(const LAS bf16x8*)(q + j * 1024), q1 = *(const LAS bf16x8*)(q + j * 1024 + 512);
        f32x4 s0 = __builtin_amdgcn_mfma_f32_16x16x32_bf16(f.k[0], q0, z, 0, 0, 0); s0 = __builtin_amdgcn_mfma_f32_16x16x32_bf16(f.k[1], q1, s0, 0, 0, 0);
        f32x4 s1 = __builtin_amdgcn_mfma_f32_16x16x32_bf16(f.k[2], q0, z, 0, 0, 0); s1 = __builtin_amdgcn_mfma_f32_16x16x32_bf16(f.k[3], q1, s1, 0, 0, 0);
        float sv[8];
#pragma unroll
        for (int e = 0; e < 4; ++e) { sv[e] = s0[e]; sv[4 + e] = s1[e]; }
        if (LOCAL) { const int qc = 16 * j + kq; const int cs = min(max(qc - 8, 0), 48); const LAS float* bp = brow + (kc0 - qc + 15);
#pragma unroll
            for (int e = 0; e < 8; ++e) { const int ko = (e >> 2) * 16 + (e & 3); const float bias = bp[ko]; sv[e] = ((unsigned)(kc0 + ko - cs) < 16u) ? sv[e] + bias : -INFINITY; } }
        float mx = fmaxf(fmaxf(fmaxf(sv[0], sv[1]), fmaxf(sv[2], sv[3])), fmaxf(fmaxf(sv[4], sv[5]), fmaxf(sv[6], sv[7])));
        mx = xmax16(mx); mx = xmax32(mx);
        const float mnew = fmaxf(mr[j], mx); const float alpha = __builtin_amdgcn_exp2f(mr[j] - mnew);
        float p[8]; float ps = 0.f;
#pragma unroll
        for (int e = 0; e < 8; ++e) { p[e] = __builtin_amdgcn_exp2f(sv[e] - mnew); ps += p[e]; }
        lr[j] = lr[j] * alpha + ps;
        if (__builtin_amdgcn_ballot_w64(mnew > mr[j]) != 0ull) {
#pragma unroll
            for (int dt = 0; dt < 4; ++dt) o[4 * j + dt] *= alpha; }
        mr[j] = mnew;
        v4u pb; pb.x = pk2(p[0], p[1]); pb.y = pk2(p[2], p[3]); pb.z = pk2(p[4], p[5]); pb.w = pk2(p[6], p[7]);
        const bf16x8 pf = __builtin_bit_cast(bf16x8, pb);
#pragma unroll
        for (int dt = 0; dt < 4; ++dt) o[4 * j + dt] = __builtin_amdgcn_mfma_f32_16x16x32_bf16(f.v[dt], pf, o[4 * j + dt], 0, 0, 0);
        __builtin_amdgcn_sched_barrier(0);
    }
}
__device__ __forceinline__ void attn_item(const bf16* QP, const bf16* KP, const bf16* VP, bf16* Y, const LAS float* btab, LAS bf16* qw, int h, int qt16, int lt32, int ct32, int yrow0, int rs, int r, int lane) {
    const int kq = lane & 15, quad = lane >> 4;
    LAS bf16* q = qw + lane * 8;
#pragma unroll
    for (int j = 0; j < 4; ++j) { const bf16* qp = QP + ((size_t)(qt16 + j) * 8 + h) * 1024 + lane * 8; const bf16x8 a0 = *(const bf16x8*)qp, a1 = *(const bf16x8*)(qp + 512);
        *(LAS bf16x8*)(q + j * 1024) = a0; *(LAS bf16x8*)(q + j * 1024 + 512) = a1; }
    LDS_WAIT(); asm volatile("" ::: "memory");
    f32x4 o[16]; float mr[4], lr[4];
#pragma unroll
    for (int i = 0; i < 16; ++i) o[i] = (f32x4){0.f, 0.f, 0.f, 0.f};
#pragma unroll
    for (int j = 0; j < 4; ++j) { mr[j] = -1e30f; lr[j] = 0.f; }
    KV f0, f1;
    if (lt32 >= 0) {
        kv_load(f0, KP, VP, lt32, h, lane);
#pragma unroll 1
        for (int ir = 0; ir < 8; ++ir) {
            const LAS float* brow = btab + (rs + ir - r + 7) * 31;
            kv_load(f1, KP, VP, lt32 + 2 * ir + 1, h, lane);
            attn_chunk<0x7, true>(f0, q, o, mr, lr, brow, 4 * quad, kq);
            kv_load(f0, KP, VP, ir < 7 ? lt32 + 2 * ir + 2 : ct32, h, lane);
            attn_chunk<0xE, true>(f1, q, o, mr, lr, brow, 32 + 4 * quad, kq);
        }
    } else kv_load(f0, KP, VP, ct32, h, lane);
#pragma unroll 1
    for (int c = 0; c < 8; c += 2) {
        kv_load(f1, KP, VP, ct32 + c + 1, h, lane);
        attn_chunk<0xF, false>(f0, q, o, mr, lr, btab, 0, kq);
        kv_load(f0, KP, VP, ct32 + (c < 6 ? c + 2 : 0), h, lane);
        attn_chunk<0xF, false>(f1, q, o, mr, lr, btab, 0, kq);
    }
#pragma unroll
    for (int j = 0; j < 4; ++j) { float l = lr[j]; l += __shfl_xor(l, 16); l += __shfl_xor(l, 32); const float inv = 1.0f / l;
        bf16* yp = Y + (size_t)(yrow0 + 16 * j + kq) * D + 512 + h * 64 + 4 * quad;
#pragma unroll
        for (int dt = 0; dt < 4; ++dt) { v2u w; w.x = pk2(o[4 * j + dt][0] * inv, o[4 * j + dt][1] * inv); w.y = pk2(o[4 * j + dt][2] * inv, o[4 * j + dt][3] * inv); *(v2u*)(yp + 16 * dt) = w; } }
}
__device__ __forceinline__ void mix_phase(const bf16* U, const bf16* QP, const bf16* KP, const bf16* VP, bf16* Y, const float* rpb  , const float* convw, bool with_ctx, LAS unsigned char* lds, int wave, int lane) {
    const int gw = blockIdx.x * NWAVES + wave, NGW = gridDim.x * NWAVES;
    constexpr int NA = BATCH * 32 * 8, NC = BATCH * 8 * 4;
    const int nc = with_ctx ? NC : 0, nt = with_ctx ? MT : MLAT, total = NA + nc + nt;
    LAS bf16* qw = (LAS bf16*)(lds + 20480 + wave * 8192);
    LAS float* btab = (LAS float*)(lds + wave * 2560) + 64;
    int cur_h = -1;
    const int lane0 = lane;
    for (int it = gw; it < total; it += NGW) {
        int lane = lane0; asm volatile("" : "+v"(lane));
        if (it < NA) { const int h = it & 7, r = (it >> 3) & 31, b = it >> 8;
            if (h != cur_h) { for (int i = lane; i < 465; i += 64) btab[i] = rpb[h * 465 + i] * 1.44269504089f; cur_h = h; LDS_WAIT(); asm volatile("" ::: "memory"); }
            const int rs = min(max(r - 4, 0), 24);
            attn_item(QP, KP, VP, Y, btab, qw, h, b * 128 + r * 4, b * 64 + rs * 2, 512 + b * 8, b * SEQ + r * 64, rs, r, lane);
        } else if (it < NA + nc) { const int x = it - NA; const int g4 = x & 3, h = (x >> 2) & 7, b = x >> 5;
            attn_item(QP, KP, VP, Y, btab, qw, h, 1024 + b * 16 + 4 * g4, -1, 512 + b * 8, MLAT + b * CTX + 64 * g4, 0, 0, lane);
        } else convpool_token(U, Y, convw, it - NA - nc, lane);
    }
}
#define XB_TMO      128
#define XB_XCNT(j)  (256  + 64 * (j))
#define XB_XSUB(j)  (1280 + 64 * (j))
#define XB_XGEN(j)  (2304 + 64 * (j))
#define XB_TOP      3328
#define XB_TOPGEN   3392
#define XCD_BAR_WORDS 3456
#define XB_SPIN_CAP (1u << 18)

__device__ __forceinline__ unsigned xb_ld(unsigned* p)              { return __hip_atomic_load(p, __ATOMIC_RELAXED, __HIP_MEMORY_SCOPE_AGENT); }
__device__ __forceinline__ unsigned xb_add(unsigned* p, unsigned v) { return __hip_atomic_fetch_add(p, v, __ATOMIC_RELAXED, __HIP_MEMORY_SCOPE_AGENT); }
__device__ __forceinline__ unsigned xb_xcc_id() { return (unsigned)__builtin_amdgcn_s_getreg((3 << 11) | 20) & 0xFu; }
#define XB_SPIN(cond, bar) do { unsigned _sp = 0; while (cond) { __builtin_amdgcn_s_sleep(1); \
    if ((++_sp & 255u) == 0u) { if (xb_ld(&(bar)[XB_TMO])) break; if (_sp > XB_SPIN_CAP) { atomicAdd(&(bar)[XB_TMO], 1u); break; } } } } while (0)

struct XcdBarrier {
    unsigned* bar; unsigned x;
    volatile LAS unsigned* st;
};

__device__ __forceinline__ XcdBarrier xcd_barrier_post(unsigned* bar, volatile LAS unsigned* st) {
    XcdBarrier b; b.bar = bar; b.x = xb_xcc_id(); b.st = st;
    if (threadIdx.x == 0) (void)xb_add(&bar[XB_XCNT(b.x)], 1u);
    return b;
}
__device__ __forceinline__ void xcd_barrier_complete(unsigned* bar, unsigned x, unsigned& nloc, unsigned& nx) {
    const unsigned G = gridDim.x * gridDim.y * gridDim.z;
    unsigned sum, cnt, mine, sp = 0u;
    for (;;) {
        sum = 0u; cnt = 0u; mine = 0u;
#pragma unroll
        for (unsigned j = 0; j < 16; ++j) { const unsigned c = xb_ld(&bar[XB_XCNT(j)]); sum += c; cnt += (c > 0u) ? 1u : 0u; mine = (j == x) ? c : mine; }
        if (sum == G) break;
        __builtin_amdgcn_s_sleep(1);
        if ((++sp & 255u) == 0u) { if (xb_ld(&bar[XB_TMO])) break; if (sp > XB_SPIN_CAP) { atomicAdd(&bar[XB_TMO], 1u); break; } }
    }
    nloc = mine > 0u ? mine : 1u; nx = cnt > 0u ? cnt : 1u;
}

__device__ __forceinline__ void xcd_barrier(const XcdBarrier& b) {
    asm volatile("s_waitcnt vmcnt(0)" ::: "memory");
    __syncthreads();
    if (threadIdx.x == 0) {
        unsigned* bar = b.bar;
        __builtin_amdgcn_s_waitcnt(0);
        unsigned nloc = b.st[0], nx = b.st[1];
        if (nloc == 0u) { xcd_barrier_complete(bar, b.x, nloc, nx); b.st[0] = nloc; b.st[1] = nx; }
        const unsigned old = xb_add(&bar[XB_XSUB(b.x)], 1u);
        const unsigned gen = old / nloc;
        if (old + 1u == (gen + 1u) * nloc) {
            __builtin_amdgcn_fence(__ATOMIC_RELEASE, "agent");
            asm volatile("s_waitcnt vmcnt(0)" ::: "memory");
            const unsigned og = xb_add(&bar[XB_TOP], 1u);
            const unsigned tg = og / nx;
            if (og + 1u == (tg + 1u) * nx) xb_add(&bar[XB_TOPGEN], 1u);
            else XB_SPIN(xb_ld(&bar[XB_TOPGEN]) == tg, bar);
            __builtin_amdgcn_fence(__ATOMIC_ACQUIRE, "agent");
            xb_add(&bar[XB_XGEN(b.x)], 1u);
            asm volatile("s_waitcnt vmcnt(0)" ::: "memory");
        } else {
            XB_SPIN(xb_ld(&bar[XB_XGEN(b.x)]) == gen, bar);
            __builtin_amdgcn_fence(__ATOMIC_ACQUIRE, "agent");
            asm volatile("s_waitcnt vmcnt(0)" ::: "memory");
        }
    }
    __syncthreads();
}
constexpr int N_STEPS = 22;
__global__ void __launch_bounds__(NTHREADS, 2) fwd(Args a) {
    extern __shared__ __attribute__((aligned(16))) unsigned char lds_raw[];
    LAS unsigned char* lds = (LAS unsigned char*)lds_raw;
    unsigned char* ws = a.ws;
    float* MOD = (float*)(ws + WS_MOD);
    float* Xl = a.out; float* Xc = (float*)(ws + WS_XC);
    bf16* XN = (bf16*)(ws + WS_XN); bf16* Hb = (bf16*)(ws + WS_H); bf16* Ub = (bf16*)(ws + WS_H); bf16* Yb = (bf16*)(ws + WS_Y);
    bf16* QPb = (bf16*)(ws + WS_QP); bf16* KPb = (bf16*)(ws + WS_KP); bf16* VPb = (bf16*)(ws + WS_VP);
    XcdBarrier bar; bar.bar = (unsigned*)(ws + WS_CTL); bar.x = 0; bar.st = nullptr;
    if (a.coop) { volatile LAS unsigned* MISC = (volatile LAS unsigned*)(lds + MISC_OFF);
        if (threadIdx.x < 32) MISC[threadIdx.x] = 0u;
        __syncthreads();
        bar = xcd_barrier_post((unsigned*)(ws + WS_CTL), MISC + 8); }
    for (int st2 = 2 * a.ph_lo; st2 < 2 * a.ph_hi; ++st2) {
        const int st = st2 >> 1;
        if (st2 & 1) { bool dup = false; const int kk = (st - 1) % 10;
            if (PROBE_DUP == 1) dup = (st >= 1 && st < N_STEPS - 1 && (kk == 0 || kk == 3 || kk == 7));
            if (PROBE_DUP == 2) dup = st >= 1 && st < N_STEPS - 1 && kk == 5;
            if (PROBE_DUP == 3) dup = true;
            if (PROBE_DUP == 4) dup = st == 0;
            if (PROBE_DUP == 5) dup = st >= 1 && st < N_STEPS - 1 && (kk == 1 || kk == 8);
            if (PROBE_DUP == 6) dup = st >= 1 && st < N_STEPS - 1 && kk == 4;
            if (!dup) continue; }
        const bool skip_body = (PROBE_DUP == 3) && (st2 & 1);
        int tid_l = threadIdx.x; asm volatile("" : "+v"(tid_l));
        const int tid = tid_l, lane = tid & 63, wave = __builtin_amdgcn_readfirstlane(tid >> 6);
        if (skip_body) {}
        else if (st == 0) prologue(a, lds, tid, wave, lane);
        else if (st == N_STEPS - 1) final_phase(Xl, a.in[I_FINALG], wave, lane);
        else {
            const int l = (st - 1) / 10, k = (st - 1) % 10;
            const float* modl = MOD + (size_t)l * 9 * NMODC;
            unsigned char* wb = ws + WS_W + (size_t)l * W_LAYER;
            const bool first = (l == 0 && k <= 2);
            const float* sl = first ? a.in[I_X] : Xl; const float* sx = first ? a.in[I_CTX] : Xc;
            const int rows = (l == 1 && k >= 5) ? MLAT : MT;
            if (st == 1) wout_transposes(a, lds, wave, lane);
            if (k == 0 || k == 3 || k == 7) { const int s = k == 0 ? 0 : (k == 3 ? 1 : 2);
                norm_phase(sl, sx, XN, a.in[I_NORMG] + (size_t)(l * 3 + s) * D, modl, s, rows, wave, lane);
            } else if (k == 1 || k == 8) {
                pg8::Gemm g{XN, (const bf16*)(wb + (k == 1 ? WO_W1A : WO_W1B)), rows, 2 * DFF, D}; pg8::StaticOrder S; S.init(rows, 2 * DFF, gridDim.x, blockIdx.x);
                pg8::EpiSwiglu E{Hb, DFF};
#ifndef NO_SW
                pg8::gemm_phase<pg8::EpiSwiglu, pg8::StaticOrder, true, true>(lds, g, S, E);
#endif
            } else if (k == 2 || k == 9 || k == 6) {
                const bf16* A = (k == 6) ? Yb : Hb; const bf16* Bt = (const bf16*)(wb + (k == 2 ? WO_W2A : (k == 9 ? WO_W2B : WO_WOUT)));
                const int K = (k == 6) ? D : DFF; const int gi = (k == 2) ? 2 : (k == 6 ? 5 : 8);
                pg8::Gemm g{A, Bt, rows, D, K}; pg8::StaticOrder S; S.init(rows, D, gridDim.x, blockIdx.x);
                pg8::EpiResid E{sl, sx, Xl, Xc, modl + gi * D, (k == 6) ? 1.0f : 0.5f};
#ifndef NO_RS
                pg8::gemm_phase<pg8::EpiResid, pg8::StaticOrder, true, true>(lds, g, S, E);
#endif
            } else if (k == 4) {
                pg8::Gemm g{XN, (const bf16*)(wb + WO_WIN), rows, 2560, D}; pg8::StaticOrder S; S.init(rows, 2560, gridDim.x, blockIdx.x);
                pg8::EpiU E{Ub, QPb, KPb, VPb};
#ifndef NO_U
                pg8::gemm_phase<pg8::EpiU, pg8::StaticOrder, true, true>(lds, g, S, E);
#endif
            } else {
#ifndef NO_MIX
                mix_phase(Ub, QPb, KPb, VPb, Yb, a.in[I_RPB] + (size_t)l * 8 * 465, a.in[I_CONVW] + (size_t)l * 768, l == 0, lds, wave, lane);
#endif
            }
        }
        if (a.coop == 2) cg::this_grid().sync();
        if (a.coop && (st2 + 2 < 2 * a.ph_hi || PROBE_DUP != 0)) xcd_barrier(bar);
    }
}

extern "C" void kernel_launch(void* const* d_in, const int* in_sizes, int n_in, void* d_out, int out_size, void* d_ws, size_t ws_size, hipStream_t stream) {
    static int grid = 0;
    if (grid == 0) {
        if (n_in != 16 || in_sizes[0] != MLAT * D || out_size != MLAT * D || ws_size < WS_END) { fprintf(stderr, "kernel_launch: unexpected shapes (n_in %d, in0 %d, out %d, ws %zu)\n", n_in, n_in > 0 ? in_sizes[0] : -1, out_size, ws_size); grid = -1; return; }
        int dev = 0, cus = 0, per_cu = 0;
        if (hipGetDevice(&dev) != hipSuccess || hipDeviceGetAttribute(&cus, hipDeviceAttributeMultiprocessorCount, dev) != hipSuccess) { grid = -1; return; }
        if (hipFuncSetAttribute((const void*)fwd, hipFuncAttributeMaxDynamicSharedMemorySize, LDS_BYTES) != hipSuccess) { fprintf(stderr, "kernel_launch: hipFuncSetAttribute failed\n"); grid = -1; return; }
        if (hipOccupancyMaxActiveBlocksPerMultiprocessor(&per_cu, (const void*)fwd, NTHREADS, LDS_BYTES) != hipSuccess || per_cu < 1) { fprintf(stderr, "kernel_launch: occupancy query says %d blocks per CU\n", per_cu); grid = -1; (void)hipGetLastError(); return; }
        grid = cus;
    }
    if (grid < 0) return;
    if (MK_COOP && hipMemsetAsync((char*)d_ws + WS_CTL, 0, CTL_ZERO_BYTES, stream) != hipSuccess) { fprintf(stderr, "kernel_launch: memset of the barrier words failed\n"); return; }
    Args a{};
    for (int i = 0; i < 16; ++i) a.in[i] = (const float*)d_in[i];
    a.out = (float*)d_out; a.ws = (unsigned char*)d_ws;
#if MK_COOP
    a.ph_lo = 0; a.ph_hi = N_STEPS; a.coop = 1;
    void* args[] = {&a};
    hipError_t e = hipLaunchCooperativeKernel((const void*)fwd, dim3(grid), dim3(NTHREADS), args, LDS_BYTES, stream);
    if (e != hipSuccess) fprintf(stderr, "kernel_launch: cooperative launch failed: %s (grid %d)\n", hipGetErrorString(e), grid);
#else
    for (int st = 0; st < N_STEPS; ++st) { a.ph_lo = st; a.ph_hi = st + 1; a.coop = 0;
        hipLaunchKernelGGL(fwd, dim3(grid), dim3(NTHREADS), LDS_BYTES, stream, a); }
#endif
}
```
